# Optimizing an MI355X kernel written in HIP

```python
import math
import jax, jax.numpy as jnp
from jax import lax
import numpy as np

D_MODEL = 2048
BATCH = 2
SEQ = 4096
DEPTH = 1

CHUNK = 64
D_CONV = 1024
CONV_HEADS = 16
CONV_WIDTH = 3
D_SSM = 1024
SSM_GROUP = 16
SSM_GROUPS = D_SSM // SSM_GROUP
SSM_STATE = 64
D_MIX = D_CONV + D_SSM
N_IN = 4 * D_CONV + 2 * D_SSM
DT_MIN = 1e-3
DT_MAX = 1e-1
EPS = 1e-6

kernel_name = "hybrid_shortconv_s5_block"


def rms_norm(x, g):
    xf = x.astype(jnp.float32)
    y = xf * lax.rsqrt(jnp.mean(xf * xf, axis=-1, keepdims=True) + EPS)
    return (y * g.astype(jnp.float32)).astype(x.dtype)


def causal_dwconv(h, w, b):
    L = h.shape[1]
    hp = jnp.pad(h, ((0, 0), (CONV_WIDTH - 1, 0), (0, 0)))
    out = b[None, None, :]
    for k in range(CONV_WIDTH):
        out = out + w[k][None, None, :] * hp[:, k:k + L, :]
    return out


def _scan_combine(e1, e2):
    a1r, a1i, b1r, b1i = e1
    a2r, a2i, b2r, b2i = e2
    ar = a2r * a1r - a2i * a1i
    ai = a2r * a1i + a2i * a1r
    br = a2r * b1r - a2i * b1i + b2r
    bi = a2r * b1i + a2i * b1r + b2i
    return (ar, ai, br, bi)


def s5_branch(u, a_re, a_im, log_dt, b_re, b_im, c_re, c_im, d_skip, w_glu, b_glu):
    f32 = jnp.float32
    uf = u.astype(f32)
    Bsz, L, _ = uf.shape
    ug = uf.reshape(Bsz, L, SSM_GROUPS, SSM_GROUP)
    lr, li = a_re.astype(f32), a_im.astype(f32)
    dt = jnp.exp(log_dt.astype(f32))[:, None]
    mag = jnp.exp(lr * dt)
    lbr, lbi = mag * jnp.cos(li * dt), mag * jnp.sin(li * dt)
    nr, ni = lbr - 1.0, lbi
    den = lr * lr + li * li
    qr = (nr * lr + ni * li) / den
    qi = (ni * lr - nr * li) / den
    br_, bi_ = b_re.astype(f32), b_im.astype(f32)
    bbr = qr[..., None] * br_ - qi[..., None] * bi_
    bbi = qr[..., None] * bi_ + qi[..., None] * br_
    bu_r = jnp.einsum('blgh,gph->blgp', ug, bbr)
    bu_i = jnp.einsum('blgh,gph->blgp', ug, bbi)
    ar = jnp.broadcast_to(lbr[None, None], bu_r.shape)
    ai = jnp.broadcast_to(lbi[None, None], bu_i.shape)
    _, _, s_r, s_i = lax.associative_scan(_scan_combine, (ar, ai, bu_r, bu_i), axis=1)
    y = (jnp.einsum('ghp,blgp->blgh', c_re.astype(f32), s_r)
         - jnp.einsum('ghp,blgp->blgh', c_im.astype(f32), s_i))
    y = y.reshape(Bsz, L, D_SSM) + d_skip.astype(f32)[None, None, :] * uf
    y = jax.nn.gelu(y)
    y = y * jax.nn.sigmoid(y @ w_glu.astype(f32) + b_glu.astype(f32))
    return y.astype(u.dtype)


def setup_inputs(seed: int = 0) -> dict:
    key = jax.random.key(seed)
    ks = jax.random.split(key, 20)
    f32 = jnp.float32
    x = jax.random.normal(ks[0], (BATCH, SEQ, D_MODEL), f32)
    norm_pre_g = 1.0 + 0.05 * jax.random.normal(ks[1], (D_MODEL,), f32)
    w_in = jax.random.normal(ks[2], (D_MODEL, N_IN), f32) * D_MODEL ** -0.5
    conv_w = jax.random.normal(ks[3], (CONV_WIDTH, D_CONV), f32) * CONV_WIDTH ** -0.5
    conv_b = 0.02 * jax.random.normal(ks[4], (D_CONV,), f32)
    n = jnp.arange(SSM_STATE, dtype=f32)[None, :]
    ssm_a_re = -0.5 + 0.01 * jax.random.normal(ks[5], (SSM_GROUPS, SSM_STATE), f32)
    ssm_a_im = math.pi * n + 0.01 * jax.random.normal(ks[6], (SSM_GROUPS, SSM_STATE), f32)
    ssm_log_dt = jax.random.uniform(ks[7], (SSM_GROUPS,), f32, math.log(DT_MIN), math.log(DT_MAX))
    bs = (2.0 * SSM_GROUP) ** -0.5
    ssm_b_re = jax.random.normal(ks[8], (SSM_GROUPS, SSM_STATE, SSM_GROUP), f32) * bs
    ssm_b_im = jax.random.normal(ks[9], (SSM_GROUPS, SSM_STATE, SSM_GROUP), f32) * bs
    cs = (2.0 * SSM_STATE) ** -0.5
    ssm_c_re = jax.random.normal(ks[10], (SSM_GROUPS, SSM_GROUP, SSM_STATE), f32) * cs
    ssm_c_im = jax.random.normal(ks[11], (SSM_GROUPS, SSM_GROUP, SSM_STATE), f32) * cs
    ssm_d = jax.random.normal(ks[12], (D_SSM,), f32)
    w_glu = jax.random.normal(ks[13], (D_SSM, D_SSM), f32) * D_SSM ** -0.5
    b_glu = 0.02 * jax.random.normal(ks[14], (D_SSM,), f32)
    w_out = jax.random.normal(ks[15], (D_MIX, D_MODEL), f32) * D_MIX ** -0.5
    norm_post_g = 1.0 + 0.05 * jax.random.normal(ks[16], (D_MODEL,), f32)
    return {"x": x, "norm_pre_g": norm_pre_g, "w_in": w_in, "conv_w": conv_w, "conv_b": conv_b,
            "ssm_a_re": ssm_a_re, "ssm_a_im": ssm_a_im, "ssm_log_dt": ssm_log_dt,
            "ssm_b_re": ssm_b_re, "ssm_b_im": ssm_b_im, "ssm_c_re": ssm_c_re, "ssm_c_im": ssm_c_im,
            "ssm_d": ssm_d, "w_glu": w_glu, "b_glu": b_glu, "w_out": w_out, "norm_post_g": norm_post_g}


def reference(x, norm_pre_g, w_in, conv_w, conv_b, ssm_a_re, ssm_a_im, ssm_log_dt,
              ssm_b_re, ssm_b_im, ssm_c_re, ssm_c_im, ssm_d, w_glu, b_glu, w_out, norm_post_g):
    for _ in range(DEPTH):
        h = rms_norm(x, norm_pre_g)
        proj = h @ w_in
        b_gate, c_gate, v, z_conv = jnp.split(proj[..., :4 * D_CONV], 4, axis=-1)
        u, z_ssm = jnp.split(proj[..., 4 * D_CONV:], 2, axis=-1)
        y_conv = b_gate * causal_dwconv(c_gate * v, conv_w, conv_b)
        y_conv = y_conv * jax.nn.silu(z_conv)
        y_ssm = s5_branch(u, ssm_a_re, ssm_a_im, ssm_log_dt, ssm_b_re, ssm_b_im,
                          ssm_c_re, ssm_c_im, ssm_d, w_glu, b_glu)
        y_ssm = y_ssm * jax.nn.silu(z_ssm)
        mix = jnp.concatenate([y_conv, y_ssm], axis=-1)
        x = x + rms_norm(mix @ w_out, norm_post_g)
    return x
```

```cpp
#include <hip/hip_runtime.h>
#include <hip/hip_cooperative_groups.h>
#include <cstdio>
#include <cstdint>
namespace cg = cooperative_groups;
namespace pg8 {
#define PG8_LAS __attribute__((address_space(3)))
typedef unsigned short bf16_t;
typedef short bf16x8 __attribute__((ext_vector_type(8)));
typedef float f32x4 __attribute__((ext_vector_type(4)));
typedef unsigned u32x4 __attribute__((ext_vector_type(4)));
constexpr int BM = 256, BK = 64, HALF = 128, HTB = HALF * BK * 2  , STAGE_BYTES = 8 * HTB, NXCD = 8, WGM = 8;

__host__ __device__ __forceinline__ int lds_byte(int r, int c) { const int st = (r >> 4) * 2 + (c >> 5), rr = r & 15, cc = c & 31, ob = rr * 64 + cc * 2; return st * 1024 + (ob ^ (((ob >> 9) & 1) << 5)); }
__host__ __device__ __forceinline__ void stage_rc(int b, int& R, int& C) { const int st = b / 1024, sb = b % 1024, swz = sb ^ (((sb >> 9) & 1) << 5); R = (st >> 1) * 16 + swz / 64; C = (st & 1) * 32 + (swz % 64) / 2; }
__host__ __device__ __forceinline__ int perm32(int rho) { const int n = rho >> 4, i = rho & 15; return 8 * (i >> 2) + 4 * n + (i & 3); }

struct Unit { int pm, pn; };
struct Gemm { const bf16_t* A; const bf16_t* Bt; int M, N, K; };

struct StaticOrder {
    int nM, nN, nwg, G, c;
    __host__ __device__ void init(int M, int N, int G_, int c_) { nM = M / BM; nN = N / BM; nwg = nM * nN; G = G_; c = c_; }
    __host__ __device__ bool next(int i, Unit& u) const {
        const long L = (long)i * G + c; if (L >= nwg) return false;
        int wgid = (int)L; { const int q = nwg / NXCD, r = nwg % NXCD, xcd = wgid % NXCD, off = wgid / NXCD; wgid = (xcd < r ? xcd * (q + 1) : r * (q + 1) + (xcd - r) * q) + off; }
        const int nig = WGM * nN, gid = wgid / nig, fm = gid * WGM, gsz = (nM - fm) < WGM ? (nM - fm) : WGM;
        u.pm = fm + ((wgid % nig) % gsz); u.pn = (wgid % nig) / gsz; return true;
    }
    __device__ __forceinline__ void a_ready(const Unit&) const {}
    __device__ __forceinline__ void done(const Unit&) const {}
};

__device__ __forceinline__ unsigned cvt_pk_bf16(float lo, float hi) { unsigned r; asm volatile("v_cvt_pk_bf16_f32 %0, %1, %2" : "=v"(r) : "v"(lo), "v"(hi)); return r; }
__device__ __forceinline__ float bf_lo(unsigned w) { return __uint_as_float(w << 16); }
__device__ __forceinline__ float bf_hi(unsigned w) { return __uint_as_float(w & 0xffff0000u); }
__device__ __forceinline__ float sigmoidf_(float v) { return 1.0f / (1.0f + __expf(-v)); }

struct EpiProj {
    static constexpr bool PERM = true, AFTER_DRAIN = false;
    bf16_t* O; int ldc;
    __device__ __forceinline__ void operator()(const f32x4 (&acc)[2][2][4][2], const Unit& u, int wr, int wc, int fr, int fq) const {
        const int row0 = u.pm * BM + wr * 64 + fr; const int col0 = u.pn * BM + wc * 32 + 8 * fq;
#pragma unroll
        for (int ai = 0; ai < 2; ++ai)
#pragma unroll
            for (int m = 0; m < 4; ++m) { bf16_t* rowp = O + (size_t)(row0 + ai * HALF + m * 16) * ldc + col0;
#pragma unroll
                for (int bj = 0; bj < 2; ++bj) { const f32x4 v0 = acc[ai][bj][m][0], v1 = acc[ai][bj][m][1];
                    u32x4 w; w.x = cvt_pk_bf16(v0[0], v0[1]); w.y = cvt_pk_bf16(v0[2], v0[3]); w.z = cvt_pk_bf16(v1[0], v1[1]); w.w = cvt_pk_bf16(v1[2], v1[3]);
                    *(u32x4*)(rowp + bj * HALF) = w; } }
    }
};
struct EpiGlu {
    static constexpr bool PERM = true, AFTER_DRAIN = false;
    const bf16_t* YG; const bf16_t* Z; int ldz; const float* bias; bf16_t* O; int ldo;
    __device__ __forceinline__ void operator()(const f32x4 (&acc)[2][2][4][2], const Unit& u, int wr, int wc, int fr, int fq) const {
        const int row0 = u.pm * BM + wr * 64 + fr; const int col0 = u.pn * BM + wc * 32 + 8 * fq;
        f32x4 bv[2][2];
#pragma unroll
        for (int bj = 0; bj < 2; ++bj)
#pragma unroll
            for (int n = 0; n < 2; ++n) bv[bj][n] = *(const f32x4*)(bias + col0 + bj * HALF + 4 * n);
#pragma unroll
        for (int ai = 0; ai < 2; ++ai)
#pragma unroll
            for (int m = 0; m < 4; ++m) { const size_t row = (size_t)(row0 + ai * HALF + m * 16);
#pragma unroll
                for (int bj = 0; bj < 2; ++bj) { const int c = col0 + bj * HALF;
                    const u32x4 yw = *(const u32x4*)(YG + row * 1024 + c); const u32x4 zw = *(const u32x4*)(Z + row * ldz + c);
                    const f32x4 g0 = acc[ai][bj][m][0] + bv[bj][0], g1 = acc[ai][bj][m][1] + bv[bj][1];
                    float o[8]; const float gg[8] = {g0[0], g0[1], g0[2], g0[3], g1[0], g1[1], g1[2], g1[3]};
                    const unsigned yy[4] = {yw.x, yw.y, yw.z, yw.w}, zz[4] = {zw.x, zw.y, zw.z, zw.w};
#pragma unroll
                    for (int e = 0; e < 4; ++e) { const float y0 = bf_lo(yy[e]), y1 = bf_hi(yy[e]), z0 = bf_lo(zz[e]), z1 = bf_hi(zz[e]);
                        o[2 * e] = y0 * sigmoidf_(gg[2 * e]) * (z0 * sigmoidf_(z0)); o[2 * e + 1] = y1 * sigmoidf_(gg[2 * e + 1]) * (z1 * sigmoidf_(z1)); }
                    u32x4 w; w.x = cvt_pk_bf16(o[0], o[1]); w.y = cvt_pk_bf16(o[2], o[3]); w.z = cvt_pk_bf16(o[4], o[5]); w.w = cvt_pk_bf16(o[6], o[7]);
                    *(u32x4*)(O + row * ldo + c) = w; } }
    }
};
struct EpiOut {
    static constexpr bool PERM = false, AFTER_DRAIN = false;
    float* O; int ldc; float* SSQ;
    __device__ __forceinline__ void operator()(const f32x4 (&acc)[2][2][4][2], const Unit& u, int wr, int wc, int fr, int fq) const {
        const int row0 = u.pm * BM + wr * 64 + fr; const int col0 = u.pn * BM + wc * 32 + 4 * fq;
#pragma unroll
        for (int ai = 0; ai < 2; ++ai)
#pragma unroll
            for (int m = 0; m < 4; ++m) { const size_t row = (size_t)(row0 + ai * HALF + m * 16); float s = 0.f;
#pragma unroll
                for (int bj = 0; bj < 2; ++bj)
#pragma unroll
                    for (int n = 0; n < 2; ++n) { const f32x4 v = acc[ai][bj][m][n]; s += (v[0] * v[0] + v[1] * v[1]) + (v[2] * v[2] + v[3] * v[3]);
                        *(f32x4*)(O + row * ldc + col0 + bj * HALF + n * 16) = v; }
                s += __shfl_xor(s, 16); s += __shfl_xor(s, 32);
                if (fq == 0) SSQ[row * 32 + u.pn * 4 + wc] = s; }
    }
};

template <class Epi, class Sched, bool ALIGN_EPI = false, bool SP2 = false>
__device__ __forceinline__ void gemm_phase(PG8_LAS unsigned char* lds, const Gemm g, const Sched& S, const Epi& E) {
    const int tid = threadIdx.x, wid = __builtin_amdgcn_readfirstlane(tid >> 6), lane = tid & 63, wr = wid >> 2, wc = wid & 3, fr = lane & 15, fq = lane >> 4;
    const int K = g.K, nt = K / BK;
    unsigned voffA[2], voffB[2];
#pragma unroll
    for (int i = 0; i < 2; ++i) { int R, C; stage_rc(tid * 16 + i * 8192, R, C); const int Rb = Epi::PERM ? ((R & ~31) + perm32(R & 31)) : R;
        voffA[i] = (unsigned)(R * K + C) * 2u; voffB[i] = (unsigned)(Rb * K + C) * 2u; }
    const size_t kstep = (size_t)(BK * 2);
    const size_t hstep = (size_t)HALF * K * 2;
    const size_t tstep = 2 * hstep;
    const unsigned ldsw = (unsigned)wid * 1024u;
    const int aoff = lds_byte(wr * 64 + fr, fq * 8), boff = lds_byte(wc * 32 + fr, fq * 8);
#define PG8_SA(b, h) (((b) * 2 + (h)) * HTB)
#define PG8_SB(b, h) ((4 + (b) * 2 + (h)) * HTB)
#define PG8_STAGE(bufoff, gbase, voff) do { _Pragma("unroll") for (int _i = 0; _i < 2; ++_i) \
        __builtin_amdgcn_global_load_lds((const unsigned*)((const char*)(gbase) + (voff)[_i]), (PG8_LAS unsigned*)(lds + (bufoff) + ldsw + _i * 8192), 16, 0, 0); } while (0)
#define PG8_LDA(dst, b, h) do { _Pragma("unroll") for (int m = 0; m < 4; ++m) _Pragma("unroll") for (int k = 0; k < 2; ++k) dst[m][k] = *(const PG8_LAS bf16x8*)(lds + PG8_SA(b, h) + aoff + m * 2048 + k * 1024); } while (0)
#define PG8_LDB(dst, b, h) do { _Pragma("unroll") for (int n = 0; n < 2; ++n) _Pragma("unroll") for (int k = 0; k < 2; ++k) dst[n][k] = *(const PG8_LAS bf16x8*)(lds + PG8_SB(b, h) + boff + n * 2048 + k * 1024); } while (0)
#define PG8_MMA(ai, bj, At, Bt) do { __builtin_amdgcn_s_setprio(1); _Pragma("unroll") for (int m = 0; m < 4; ++m) _Pragma("unroll") for (int n = 0; n < 2; ++n) _Pragma("unroll") for (int k = 0; k < 2; ++k) \
        acc[ai][bj][m][n] = __builtin_amdgcn_mfma_f32_16x16x32_bf16(Bt[n][k], At[m][k], acc[ai][bj][m][n], 0, 0, 0); __builtin_amdgcn_s_setprio(0); } while (0)
#define PG8_WAIT_V(n) asm volatile("s_waitcnt vmcnt(" #n ")" ::: "memory")
#define PG8_WAIT_L(n) asm volatile("s_waitcnt lgkmcnt(" #n ")" ::: "memory")
#define PG8_BAR __builtin_amdgcn_s_barrier()
#define PG8_SCHED __builtin_amdgcn_sched_barrier(0)
    Unit cur, nxt; int ui = 0;
    if (!S.next(0, cur)) return;
    f32x4 acc[2][2][4][2];
#pragma unroll
    for (int a = 0; a < 2; ++a)
#pragma unroll
        for (int b = 0; b < 2; ++b)
#pragma unroll
            for (int m = 0; m < 4; ++m)
#pragma unroll
                for (int n = 0; n < 2; ++n) acc[a][b][m][n] = (f32x4){0.f, 0.f, 0.f, 0.f};
    bf16x8 At[4][2], B0[2][2], B1[2][2];
    const char* cA = (const char*)g.A + (size_t)cur.pm * tstep; const char* cB = (const char*)g.Bt + (size_t)cur.pn * tstep;
    S.a_ready(cur);
    if constexpr (SP2) {
        PG8_STAGE(PG8_SB(0, 0), cB, voffB); PG8_STAGE(PG8_SB(0, 1), cB + hstep, voffB); PG8_STAGE(PG8_SA(0, 0), cA, voffA); PG8_STAGE(PG8_SA(0, 1), cA + hstep, voffA);
        if (wr == 1) PG8_BAR;
        PG8_WAIT_V(2); PG8_BAR;
        PG8_STAGE(PG8_SB(1, 0), cB + kstep, voffB); PG8_STAGE(PG8_SA(1, 0), cA + kstep, voffA); PG8_STAGE(PG8_SB(1, 1), cB + hstep + kstep, voffB);
        PG8_WAIT_V(6); PG8_BAR;
    } else {
        PG8_STAGE(PG8_SB(0, 0), cB, voffB); PG8_STAGE(PG8_SA(0, 0), cA, voffA); PG8_STAGE(PG8_SB(0, 1), cB + hstep, voffB); PG8_STAGE(PG8_SA(0, 1), cA + hstep, voffA);
        if (wr == 1) PG8_BAR;
        PG8_WAIT_V(4); PG8_BAR;
        PG8_STAGE(PG8_SB(1, 0), cB + kstep, voffB); PG8_STAGE(PG8_SA(1, 0), cA + kstep, voffA); PG8_STAGE(PG8_SB(1, 1), cB + hstep + kstep, voffB);
        PG8_WAIT_V(6); PG8_BAR;
    }
    for (;;) {
        const bool has_next = S.next(ui + 1, nxt);
        const char* nA = has_next ? (const char*)g.A + (size_t)nxt.pm * tstep : cA; const char* nB = has_next ? (const char*)g.Bt + (size_t)nxt.pn * tstep : cB;
        for (int t = 0; t < nt; t += 2) {
            const bool last = (t == nt - 2);
            const char* a1 = cA + (size_t)(t + 1) * kstep;
            const char* a2 = last ? nA : cA + (size_t)(t + 2) * kstep; const char* b2 = last ? nB : cB + (size_t)(t + 2) * kstep;
            const char* a3 = a2 + kstep; const char* b3 = b2 + kstep;
            if (last && has_next) S.a_ready(nxt);
            if constexpr (SP2) {
            PG8_LDB(B0, 0, 0); PG8_LDB(B1, 0, 1); PG8_SCHED; PG8_LDA(At, 0, 0); PG8_STAGE(PG8_SA(1, 1), a1 + hstep, voffA);
            PG8_WAIT_V(8); PG8_WAIT_L(0); PG8_BAR; PG8_MMA(0, 0, At, B0); PG8_MMA(0, 1, At, B1); PG8_BAR; PG8_SCHED;
            PG8_LDA(At, 0, 1); PG8_STAGE(PG8_SB(0, 0), b2, voffB); PG8_STAGE(PG8_SB(0, 1), b2 + hstep, voffB); PG8_STAGE(PG8_SA(0, 0), a2, voffA);
            PG8_WAIT_V(8); PG8_WAIT_L(0); PG8_BAR; PG8_MMA(1, 0, At, B0); PG8_MMA(1, 1, At, B1); PG8_BAR; PG8_SCHED;
            PG8_LDB(B0, 1, 0); PG8_LDB(B1, 1, 1); PG8_SCHED; PG8_LDA(At, 1, 0); PG8_STAGE(PG8_SA(0, 1), a2 + hstep, voffA);
            PG8_WAIT_V(8); PG8_WAIT_L(0); PG8_BAR; PG8_MMA(0, 0, At, B0); PG8_MMA(0, 1, At, B1); PG8_BAR; PG8_SCHED;
            PG8_LDA(At, 1, 1); PG8_STAGE(PG8_SB(1, 0), b3, voffB); PG8_STAGE(PG8_SB(1, 1), b3 + hstep, voffB); PG8_STAGE(PG8_SA(1, 0), a3, voffA);
            PG8_WAIT_V(8); PG8_WAIT_L(0); PG8_BAR; PG8_MMA(1, 0, At, B0); PG8_MMA(1, 1, At, B1); PG8_BAR; PG8_SCHED;
            } else {
            PG8_LDB(B0, 0, 0); PG8_SCHED; PG8_LDA(At, 0, 0); PG8_STAGE(PG8_SA(1, 1), a1 + hstep, voffA);
            PG8_WAIT_L(8); PG8_BAR; PG8_WAIT_L(0); PG8_MMA(0, 0, At, B0); PG8_BAR; PG8_SCHED;
            PG8_LDB(B1, 0, 1); PG8_STAGE(PG8_SB(0, 0), b2, voffB);
            PG8_BAR; PG8_WAIT_L(0); PG8_MMA(0, 1, At, B1); PG8_BAR;
            PG8_LDA(At, 0, 1); PG8_STAGE(PG8_SA(0, 0), a2, voffA);
            PG8_BAR; PG8_WAIT_L(0); PG8_MMA(1, 0, At, B0); PG8_BAR; PG8_SCHED;
            PG8_STAGE(PG8_SB(0, 1), b2 + hstep, voffB);
            PG8_WAIT_V(6); PG8_BAR; PG8_MMA(1, 1, At, B1); PG8_BAR;
            PG8_LDB(B0, 1, 0); PG8_SCHED; PG8_LDA(At, 1, 0); PG8_STAGE(PG8_SA(0, 1), a2 + hstep, voffA);
            PG8_WAIT_L(8); PG8_BAR; PG8_WAIT_L(0); PG8_MMA(0, 0, At, B0); PG8_BAR; PG8_SCHED;
            PG8_LDB(B1, 1, 1); PG8_STAGE(PG8_SB(1, 0), b3, voffB);
            PG8_BAR; PG8_WAIT_L(0); PG8_MMA(0, 1, At, B1); PG8_BAR;
            PG8_LDA(At, 1, 1); PG8_STAGE(PG8_SA(1, 0), a3, voffA);
            PG8_BAR; PG8_WAIT_L(0); PG8_MMA(1, 0, At, B0); PG8_BAR; PG8_SCHED;
            PG8_STAGE(PG8_SB(1, 1), b3 + hstep, voffB);
            PG8_WAIT_V(6); PG8_BAR; PG8_MMA(1, 1, At, B1); PG8_BAR;
            }
        }
        if constexpr (ALIGN_EPI) { if (wr == 0) PG8_BAR; }
        if constexpr (!Epi::AFTER_DRAIN) { E(acc, cur, wr, wc, fr, fq); S.done(cur); }
        if (!has_next) break;
#pragma unroll
        for (int a = 0; a < 2; ++a)
#pragma unroll
            for (int b = 0; b < 2; ++b)
#pragma unroll
                for (int m = 0; m < 4; ++m)
#pragma unroll
                    for (int n = 0; n < 2; ++n) acc[a][b][m][n] = (f32x4){0.f, 0.f, 0.f, 0.f};
        cur = nxt; cA = nA; cB = nB; ++ui;
        if constexpr (ALIGN_EPI) { if (wr == 1) PG8_BAR; }
    }
    PG8_WAIT_V(0);
    if constexpr (!ALIGN_EPI) { if (wr == 0) PG8_BAR; }
    PG8_BAR;
    if constexpr (Epi::AFTER_DRAIN) { E.fused(acc, cur, wr, wc, fr, fq, lds, wid, lane); S.done(cur); }
#undef PG8_SA
#undef PG8_SB
#undef PG8_STAGE
#undef PG8_LDA
#undef PG8_LDB
#undef PG8_MMA
#undef PG8_WAIT_V
#undef PG8_WAIT_L
#undef PG8_BAR
#undef PG8_SCHED
}
}
constexpr int NWAVES = 8, NTHREADS = NWAVES * 64;
constexpr int BATCH = 2, SEQ = 4096, DM = 2048, M = BATCH * SEQ, NIN = 6144, DC = 1024, DS = 1024, DMIX = 2048;
constexpr int NG = 64, NP = 64, NH = 16;
constexpr int CH = 64, NCHUNK = M / CH;
constexpr int SUP = 8, NSUP = NCHUNK / SUP;
constexpr float EPS = 1e-6f;
constexpr size_t MiB = 1u << 20;
constexpr size_t WS_WIN = 1 * MiB, WS_WGLU = 25 * MiB, WS_WOUT = 27 * MiB, WS_XN = 35 * MiB, WS_PROJ = 67 * MiB, WS_YG = 163 * MiB, WS_MIX = 179 * MiB;
constexpr size_t WS_SSQ = 211 * MiB, WS_CS = 212 * MiB  , WS_ES = 216 * MiB  , WS_APOW = 217 * MiB  ;
constexpr size_t WS_BBAR = 218 * MiB  , WS_CMAT = 219 * MiB  , WS_END = 220 * MiB;
constexpr int RING_BYTES = 131072, LDS_BYTES = RING_BYTES + 1024;

#define GAS __attribute__((address_space(1)))
#define LAS __attribute__((address_space(3)))
typedef unsigned short bf16;
typedef unsigned v4u __attribute__((ext_vector_type(4)));
typedef unsigned v2u __attribute__((ext_vector_type(2)));
typedef float f32x4 __attribute__((ext_vector_type(4)));
typedef float f32x2 __attribute__((ext_vector_type(2)));
typedef float f32x16 __attribute__((ext_vector_type(16)));
typedef short bf16x8 __attribute__((ext_vector_type(8)));
#define LDS_WAIT() asm volatile("s_waitcnt lgkmcnt(0)" ::: "memory")
__device__ __forceinline__ unsigned f2bf(float f) { unsigned u = __builtin_bit_cast(unsigned, f); return (u + 0x7fffu + ((u >> 16) & 1u)) >> 16; }
__device__ __forceinline__ unsigned pk2(float lo, float hi) { return f2bf(lo) | (f2bf(hi) << 16); }
__device__ __forceinline__ float bf2f(bf16 h) { return __uint_as_float((unsigned)h << 16); }
using pg8::cvt_pk_bf16; using pg8::bf_lo; using pg8::bf_hi; using pg8::sigmoidf_;

struct Args { const float* in[17]; float* out; unsigned char* ws; int ph_lo, ph_hi; };

__device__ __forceinline__ float wave_sum(float v) {
#pragma unroll
    for (int o = 1; o < 64; o <<= 1) v += __shfl_xor(v, o);
    return v;
}
__device__ __forceinline__ void p0_transpose_item(const float* W, int K, int N, bf16* WT, LAS float* scr, int item, int lane) {
    const int nblk = N / 32, kb = item / nblk, nb = item % nblk, k0 = 64 * kb, n0 = 32 * nb;
#pragma unroll 8
    for (int i = 0; i < 32; ++i) { const int kk = 2 * i + (lane >> 5); scr[kk * 33 + (lane & 31)] = W[(size_t)(k0 + kk) * N + n0 + (lane & 31)]; }
    LDS_WAIT(); asm volatile("" ::: "memory");
    const int c = lane & 7;
#pragma unroll
    for (int j = 0; j < 4; ++j) { const int n = (lane >> 3) + 8 * j; const LAS float* s = scr + (8 * c) * 33 + n;
        v4u o; o.x = pk2(s[0 * 33], s[1 * 33]); o.y = pk2(s[2 * 33], s[3 * 33]); o.z = pk2(s[4 * 33], s[5 * 33]); o.w = pk2(s[6 * 33], s[7 * 33]);
        *(GAS v4u*)(WT + (size_t)(n0 + n) * K + k0 + 8 * c) = o; }
    LDS_WAIT(); asm volatile("" ::: "memory");
}
__device__ __forceinline__ void rms_row_to_bf16(const float* xrow, const float* g, bf16* orow, int lane) {
    const GAS f32x4* xr = (const GAS f32x4*)xrow + lane; const GAS f32x4* gr = (const GAS f32x4*)g + lane;
    f32x4 v[8]; float s = 0.f;
#pragma unroll
    for (int j = 0; j < 8; ++j) { v[j] = xr[64 * j]; s += (v[j].x * v[j].x + v[j].y * v[j].y) + (v[j].z * v[j].z + v[j].w * v[j].w); }
    const float rs = 1.0f / sqrtf(wave_sum(s) * (1.f / DM) + EPS);
    GAS v2u* o8 = (GAS v2u*)orow + lane;
#pragma unroll
    for (int j = 0; j < 8; ++j) { const f32x4 gg = gr[64 * j]; v2u o; o.x = cvt_pk_bf16(v[j].x * rs * gg.x, v[j].y * rs * gg.y); o.y = cvt_pk_bf16(v[j].z * rs * gg.z, v[j].w * rs * gg.w); o8[64 * j] = o; }
}
__device__ __forceinline__ void sincos_f64(float ang, float& s, float& c) {
    const double x = (double)ang, TWO_PI = 6.283185307179586476925; const double k = rint(x / TWO_PI); const double r = x - k * TWO_PI, r2 = r * r;
    double a = 1.0, b = 1.0;
#pragma unroll
    for (int n = 14; n >= 1; --n) { a = 1.0 - a * r2 / (double)((2 * n) * (2 * n + 1)); b = 1.0 - b * r2 / (double)((2 * n - 1) * (2 * n)); }
    s = (float)(r * a); c = (float)b;
}
__device__ __forceinline__ void cmul(float& xr, float& xi, float yr, float yi) { const float r = xr * yr - xi * yi, i = xr * yi + xi * yr; xr = r; xi = i; }
__device__ __forceinline__ void p0_ssm_params(const Args& a, int gp) {
    const int g = gp >> 6, p = gp & 63;
    const float lr = a.in[5][gp], li = a.in[6][gp], dt = expf(a.in[7][g]);
    const float mag = expf(lr * dt); float sn, cs; sincos_f64(li * dt, sn, cs);
    const float lbr = mag * cs, lbi = mag * sn;
    const float nr = lbr - 1.0f, ni = lbi, den = lr * lr + li * li;
    const float qr = (nr * lr + ni * li) / den, qi = (ni * lr - nr * li) / den;
    float* ap = (float*)(a.ws + WS_APOW) + (size_t)gp * 12;
    float pr = lbr, pi = lbi; ap[0] = pr; ap[1] = pi;
    cmul(pr, pi, lbr, lbi); ap[2] = pr; ap[3] = pi;
    cmul(pr, pi, lbr, lbi); ap[4] = pr; ap[5] = pi;
    cmul(pr, pi, lbr, lbi); ap[6] = pr; ap[7] = pi;
#pragma unroll
    for (int i = 0; i < 4; ++i) cmul(pr, pi, pr, pi);
    ap[8] = pr; ap[9] = pi;
#pragma unroll
    for (int i = 0; i < 3; ++i) cmul(pr, pi, pr, pi);
    ap[10] = pr; ap[11] = pi;
    bf16* BB = (bf16*)(a.ws + WS_BBAR); bf16* CM = (bf16*)(a.ws + WS_CMAT);
    const float* bre = a.in[8] + (size_t)gp * NH; const float* bim = a.in[9] + (size_t)gp * NH;
    const int nb0 = 2 * (p >> 5), col = p & 31;
    for (int h = 0; h < NH; ++h) {
        const float br = bre[h], bi = bim[h];
        const float bbr = qr * br - qi * bi, bbi = qr * bi + qi * br;
        const int lane = (h >> 3) * 32 + col, j = h & 7;
        BB[((size_t)(g * 4 + nb0) * 64 + lane) * 8 + j] = (bf16)f2bf(bbr);
        BB[((size_t)(g * 4 + nb0 + 1) * 64 + lane) * 8 + j] = (bf16)f2bf(bbi);
        const float cr = a.in[10][((size_t)g * NH + h) * NP + p], ci = a.in[11][((size_t)g * NH + h) * NP + p];
        const int kre = 4 * (p & 31) + 2 * (p >> 5), kim = kre + 1;
        { const int kk = kre >> 5, l2 = ((kre & 31) >> 3) * 16 + h, j2 = kre & 7; CM[((size_t)(g * 4 + kk) * 64 + l2) * 8 + j2] = (bf16)f2bf(cr); }
        { const int kk = kim >> 5, l2 = ((kim & 31) >> 3) * 16 + h, j2 = kim & 7; CM[((size_t)(g * 4 + kk) * 64 + l2) * 8 + j2] = (bf16)f2bf(-ci); }
    }
}

__device__ __forceinline__ void ssm_chunk(f32x16 (&acc)[2][4], const bf16x8 (&ua)[2], const bf16x8 (&bb)[4], const float (&ar)[2][4], const float (&ai)[2][4], float (&cr)[2], float (&ci)[2], int hf) {
    const f32x16 zero = {0.f, 0.f, 0.f, 0.f, 0.f, 0.f, 0.f, 0.f, 0.f, 0.f, 0.f, 0.f, 0.f, 0.f, 0.f, 0.f};
#pragma unroll
    for (int tb = 0; tb < 2; ++tb)
#pragma unroll
        for (int nb = 0; nb < 4; ++nb) acc[tb][nb] = __builtin_amdgcn_mfma_f32_32x32x16_bf16(ua[tb], bb[nb], zero, 0, 0, 0);
#pragma unroll
    for (int st = 0; st < 2; ++st) {
        const float a1r = ar[st][0], a1i = ai[st][0];
        float er[8], ei[8];
#pragma unroll
        for (int tb = 0; tb < 2; ++tb)
#pragma unroll
            for (int q = 0; q < 4; ++q) {
                float pr = acc[tb][2 * st][4 * q], pi = acc[tb][2 * st + 1][4 * q];
#pragma unroll
                for (int i = 1; i < 4; ++i) {
                    const float nr = acc[tb][2 * st][4 * q + i] + (a1r * pr - a1i * pi), ni = acc[tb][2 * st + 1][4 * q + i] + (a1r * pi + a1i * pr);
                    acc[tb][2 * st][4 * q + i] = nr; acc[tb][2 * st + 1][4 * q + i] = ni; pr = nr; pi = ni;
                }
                er[tb * 4 + q] = pr; ei[tb * 4 + q] = pi;
            }
        float c_r = cr[st], c_i = ci[st]; const float a4r = ar[st][3], a4i = ai[st][3];
        float mr[8], mi[8];
#pragma unroll
        for (int n8 = 0; n8 < 8; ++n8) {
            const float eor = __shfl_xor(er[n8], 32), eoi = __shfl_xor(ei[n8], 32);
            const float e0r = hf ? eor : er[n8], e0i = hf ? eoi : ei[n8], e1r = hf ? er[n8] : eor, e1i = hf ? ei[n8] : eoi;
            const float cer = c_r, cei = c_i;
            float tr = a4r * c_r - a4i * c_i + e0r, ti = a4r * c_i + a4i * c_r + e0i;
            const float cor = tr, coi = ti;
            c_r = a4r * tr - a4i * ti + e1r; c_i = a4r * ti + a4i * tr + e1i;
            mr[n8] = hf ? cor : cer; mi[n8] = hf ? coi : cei;
        }
        cr[st] = c_r; ci[st] = c_i;
#pragma unroll
        for (int tb = 0; tb < 2; ++tb)
#pragma unroll
            for (int q = 0; q < 4; ++q)
#pragma unroll
                for (int i = 0; i < 4; ++i) {
                    const float wr_ = ar[st][i], wi_ = ai[st][i], xr = mr[tb * 4 + q], xi = mi[tb * 4 + q];
                    acc[tb][2 * st][4 * q + i] += wr_ * xr - wi_ * xi; acc[tb][2 * st + 1][4 * q + i] += wr_ * xi + wi_ * xr;
                }
    }
}
__device__ __forceinline__ void ssm_load_consts(const Args& a, int g, int lane, bf16x8 (&bb)[4], float (&ar)[2][4], float (&ai)[2][4], float (&a64r)[2], float (&a64i)[2], float (&a512r)[2], float (&a512i)[2]) {
    const bf16x8* BB = (const bf16x8*)(a.ws + WS_BBAR);
#pragma unroll
    for (int nb = 0; nb < 4; ++nb) bb[nb] = BB[(size_t)(g * 4 + nb) * 64 + lane];
#pragma unroll
    for (int st = 0; st < 2; ++st) {
        const f32x4* ap = (const f32x4*)((const float*)(a.ws + WS_APOW) + (size_t)(g * 64 + st * 32 + (lane & 31)) * 12);
        const f32x4 v0 = ap[0], v1 = ap[1], v2 = ap[2];
        ar[st][0] = v0.x; ai[st][0] = v0.y; ar[st][1] = v0.z; ai[st][1] = v0.w; ar[st][2] = v1.x; ai[st][2] = v1.y; ar[st][3] = v1.z; ai[st][3] = v1.w;
        a64r[st] = v2.x; a64i[st] = v2.y; a512r[st] = v2.z; a512i[st] = v2.w;
    }
}
__device__ __forceinline__ void ssm_load_u(const bf16* PROJ, int chunk, int g, int lane, bf16x8 (&ua)[2]) {
#pragma unroll
    for (int tb = 0; tb < 2; ++tb) ua[tb] = *(const bf16x8*)(PROJ + (size_t)(chunk * CH + tb * 32 + (lane & 31)) * NIN + 4 * DC + g * NH + 8 * (lane >> 5));
}
__device__ __forceinline__ void ssm_pass1(const Args& a, int item, int lane) {
    const int sup = item >> 6, g = item & 63, hf = lane >> 5;
    const bf16* PROJ = (const bf16*)(a.ws + WS_PROJ);
    bf16x8 bb[4]; float ar[2][4], ai[2][4], a64r[2], a64i[2], a512r[2], a512i[2];
    ssm_load_consts(a, g, lane, bb, ar, ai, a64r, a64i, a512r, a512i);
    float cr[2] = {0.f, 0.f}, ci[2] = {0.f, 0.f};
    f32x2* CS = (f32x2*)(a.ws + WS_CS); f32x2* ES = (f32x2*)(a.ws + WS_ES);
    for (int k = 0; k < SUP; ++k) {
        const int chunk = sup * SUP + k;
        CS[(size_t)(chunk * NG + g) * NP + hf * 32 + (lane & 31)] = hf ? (f32x2){cr[1], ci[1]} : (f32x2){cr[0], ci[0]};
        bf16x8 ua[2]; ssm_load_u(PROJ, chunk, g, lane, ua);
        f32x16 acc[2][4];
        ssm_chunk(acc, ua, bb, ar, ai, cr, ci, hf);
    }
    ES[(size_t)(sup * NG + g) * NP + hf * 32 + (lane & 31)] = hf ? (f32x2){cr[1], ci[1]} : (f32x2){cr[0], ci[0]};
}
__device__ __forceinline__ float gelu_tanh(float v) {
    const float z = 0.7978845608028654f * (v + 0.044715f * v * v * v);
    const float t = 1.0f - 2.0f / (1.0f + __expf(2.0f * z));
    return 0.5f * v * (1.0f + t);
}
__device__ __forceinline__ void ssm_pass2(const Args& a, int item, int lane, LAS unsigned char* wl) {
    const int chunk = item >> 6, g = item & 63, hf = lane >> 5, j32 = lane & 31;
    const bf16* PROJ = (const bf16*)(a.ws + WS_PROJ);
    bf16x8 bb[4]; float ar[2][4], ai[2][4], a64r[2], a64i[2], a512r[2], a512i[2];
    ssm_load_consts(a, g, lane, bb, ar, ai, a64r, a64i, a512r, a512i);
    const f32x2* CS = (const f32x2*)(a.ws + WS_CS); const f32x2* ES = (const f32x2*)(a.ws + WS_ES);
    const int sup = chunk / SUP, kin = chunk % SUP, b = sup / (NSUP / BATCH), sb = sup % (NSUP / BATCH);
    float cr[2], ci[2];
#pragma unroll
    for (int st = 0; st < 2; ++st) {
        f32x2 es[7];
#pragma unroll
        for (int s = 0; s < 7; ++s) es[s] = (s < sb) ? ES[(size_t)((b * (NSUP / BATCH) + s) * NG + g) * NP + st * 32 + j32] : (f32x2){0.f, 0.f};
        float xr = 0.f, xi = 0.f;
#pragma unroll
        for (int s = 0; s < 7; ++s) if (s < sb) { const float tr = a512r[st] * xr - a512i[st] * xi + es[s].x, ti = a512r[st] * xi + a512i[st] * xr + es[s].y; xr = tr; xi = ti; }
        float pr = 1.f, pi = 0.f;
        for (int i = 0; i < kin; ++i) cmul(pr, pi, a64r[st], a64i[st]);
        const f32x2 c0 = CS[(size_t)(chunk * NG + g) * NP + st * 32 + j32];
        cr[st] = c0.x + pr * xr - pi * xi; ci[st] = c0.y + pr * xi + pi * xr;
    }
    bf16x8 ua[2]; ssm_load_u(PROJ, chunk, g, lane, ua);
    f32x16 acc[2][4];
    ssm_chunk(acc, ua, bb, ar, ai, cr, ci, hf);
    const bf16x8* CMp = (const bf16x8*)(a.ws + WS_CMAT);
    bf16x8 cm[4];
#pragma unroll
    for (int kk = 0; kk < 4; ++kk) cm[kk] = CMp[(size_t)(g * 4 + kk) * 64 + lane];
    const int chn = g * NH + (lane & 15); const float dsk = a.in[12][chn];
    bf16* YG = (bf16*)(a.ws + WS_YG);
    constexpr int ROWB = 272;
#pragma unroll
    for (int tb = 0; tb < 2; ++tb) {
#pragma unroll
        for (int r = 0; r < 16; ++r) { const int t = (r & 3) + 8 * (r >> 2) + 4 * hf;
            v2u w; w.x = cvt_pk_bf16(acc[tb][0][r], acc[tb][1][r]); w.y = cvt_pk_bf16(acc[tb][2][r], acc[tb][3][r]);
            *(LAS v2u*)(wl + t * ROWB + 8 * j32) = w; }
        LDS_WAIT();
#pragma unroll
        for (int t16 = 0; t16 < 2; ++t16) {
            f32x4 y = {0.f, 0.f, 0.f, 0.f};
#pragma unroll
            for (int kk = 0; kk < 4; ++kk) { const bf16x8 af = *(const LAS bf16x8*)(wl + (16 * t16 + (lane & 15)) * ROWB + (32 * kk + 8 * (lane >> 4)) * 2);
                y = __builtin_amdgcn_mfma_f32_16x16x32_bf16(af, cm[kk], y, 0, 0, 0); }
#pragma unroll
            for (int r = 0; r < 4; ++r) { const size_t token = (size_t)chunk * CH + 32 * tb + 16 * t16 + 4 * (lane >> 4) + r;
                const float u = bf2f(PROJ[token * NIN + 4 * DC + chn]);
                YG[token * DS + chn] = (bf16)f2bf(gelu_tanh(y[r] + dsk * u)); }
        }
        LDS_WAIT();
    }
}
__device__ __forceinline__ void conv_item(const Args& a, int item) {
    const int cg8 = item & 127, run = item >> 7, ch0 = cg8 * 8, t0 = run * 8;
    const bf16* PROJ = (const bf16*)(a.ws + WS_PROJ); bf16* MIX = (bf16*)(a.ws + WS_MIX);
    float w0[8], w1[8], w2[8], bs[8];
#pragma unroll
    for (int e = 0; e < 8; e += 4) { const f32x4 x0 = *(const f32x4*)(a.in[3] + ch0 + e), x1 = *(const f32x4*)(a.in[3] + DC + ch0 + e), x2 = *(const f32x4*)(a.in[3] + 2 * DC + ch0 + e), x3 = *(const f32x4*)(a.in[4] + ch0 + e);
#pragma unroll
        for (int q = 0; q < 4; ++q) { w0[e + q] = x0[q]; w1[e + q] = x1[q]; w2[e + q] = x2[q]; bs[e + q] = x3[q]; } }
    float p2[8], p1[8];
    if ((t0 % SEQ) == 0) {
#pragma unroll
        for (int e = 0; e < 8; ++e) { p2[e] = 0.f; p1[e] = 0.f; }
    } else {
        const v4u c2 = *(const v4u*)(PROJ + (size_t)(t0 - 2) * NIN + DC + ch0), v2 = *(const v4u*)(PROJ + (size_t)(t0 - 2) * NIN + 2 * DC + ch0);
        const v4u c1 = *(const v4u*)(PROJ + (size_t)(t0 - 1) * NIN + DC + ch0), v1 = *(const v4u*)(PROJ + (size_t)(t0 - 1) * NIN + 2 * DC + ch0);
#pragma unroll
        for (int e = 0; e < 4; ++e) { p2[2 * e] = bf_lo(c2[e]) * bf_lo(v2[e]); p2[2 * e + 1] = bf_hi(c2[e]) * bf_hi(v2[e]); p1[2 * e] = bf_lo(c1[e]) * bf_lo(v1[e]); p1[2 * e + 1] = bf_hi(c1[e]) * bf_hi(v1[e]); }
    }
#pragma unroll 2
    for (int i = 0; i < 8; ++i) {
        const bf16* row = PROJ + (size_t)(t0 + i) * NIN + ch0;
        const v4u bw = *(const v4u*)(row), cw = *(const v4u*)(row + DC), vw = *(const v4u*)(row + 2 * DC), zw = *(const v4u*)(row + 3 * DC);
        float o[8];
#pragma unroll
        for (int e = 0; e < 4; ++e) {
            const float cv0 = bf_lo(cw[e]) * bf_lo(vw[e]), cv1 = bf_hi(cw[e]) * bf_hi(vw[e]);
            const float k0 = bs[2 * e] + w0[2 * e] * p2[2 * e] + w1[2 * e] * p1[2 * e] + w2[2 * e] * cv0;
            const float k1 = bs[2 * e + 1] + w0[2 * e + 1] * p2[2 * e + 1] + w1[2 * e + 1] * p1[2 * e + 1] + w2[2 * e + 1] * cv1;
            const float z0 = bf_lo(zw[e]), z1 = bf_hi(zw[e]);
            o[2 * e] = bf_lo(bw[e]) * k0 * (z0 * sigmoidf_(z0)); o[2 * e + 1] = bf_hi(bw[e]) * k1 * (z1 * sigmoidf_(z1));
            p2[2 * e] = p1[2 * e]; p2[2 * e + 1] = p1[2 * e + 1]; p1[2 * e] = cv0; p1[2 * e + 1] = cv1;
        }
        v4u w; w.x = cvt_pk_bf16(o[0], o[1]); w.y = cvt_pk_bf16(o[2], o[3]); w.z = cvt_pk_bf16(o[4], o[5]); w.w = cvt_pk_bf16(o[6], o[7]);
        *(v4u*)(MIX + (size_t)(t0 + i) * DMIX + ch0) = w;
    }
}
__device__ __forceinline__ void final_row(const Args& a, int row, int lane) {
    const float* SSQ = (const float*)(a.ws + WS_SSQ);
    const float part = lane < 32 ? SSQ[(size_t)row * 32 + lane] : 0.f;
    const float rs = 1.0f / sqrtf(wave_sum(part) * (1.f / DM) + EPS);
    f32x4* orow = (f32x4*)(a.out + (size_t)row * DM) + lane; const f32x4* xr = (const f32x4*)(a.in[0] + (size_t)row * DM) + lane; const f32x4* gr = (const f32x4*)a.in[16] + lane;
#pragma unroll
    for (int j = 0; j < 8; ++j) { const f32x4 o = orow[64 * j], x = xr[64 * j], g = gr[64 * j]; orow[64 * j] = x + o * rs * g; }
}

__global__ void __launch_bounds__(NTHREADS, 2) fwd_kernel(Args args) {
    extern __shared__ __attribute__((aligned(16))) unsigned char lds_raw[];
    LAS unsigned char* lds = (LAS unsigned char*)lds_raw;
    const int tid = threadIdx.x, lane = tid & 63, wave = __builtin_amdgcn_readfirstlane(tid >> 6);
    const int G = gridDim.x, gw = blockIdx.x * NWAVES + wave, NGW = G * NWAVES;
    const int lo = args.ph_lo, hi = args.ph_hi;
    unsigned char* ws = args.ws;
#define IN(k) (lo <= (k) && (k) < hi)
#define SEAM(k) do { if (IN(k) && IN((k) + 1)) { cg::this_grid().sync(); } } while (0)
    if (IN(0)) {
        LAS float* scr = (LAS float*)(lds + wave * 16384);
        constexpr int I_IN = (DM / 64) * (NIN / 32), I_GLU = (DS / 64) * (DS / 32), I_OUT = (DMIX / 64) * (DM / 32);
        for (int it = gw; it < I_IN + I_GLU + I_OUT; it += NGW) {
            int r = it;
            if (r < I_IN) { p0_transpose_item(args.in[2], DM, NIN, (bf16*)(ws + WS_WIN), scr, r, lane); continue; } r -= I_IN;
            if (r < I_GLU) { p0_transpose_item(args.in[13], DS, DS, (bf16*)(ws + WS_WGLU), scr, r, lane); continue; } r -= I_GLU;
            p0_transpose_item(args.in[15], DMIX, DM, (bf16*)(ws + WS_WOUT), scr, r, lane);
        }
        for (int m = gw; m < M; m += NGW) rms_row_to_bf16(args.in[0] + (size_t)m * DM, args.in[1], (bf16*)(ws + WS_XN) + (size_t)m * DM, lane);
        { const int gt = (G - 1 - (int)blockIdx.x) * NTHREADS + tid; if (gt < NG * NP) p0_ssm_params(args, gt); }
        __syncthreads();
    }
    SEAM(0);
    if (IN(1)) {
        pg8::Gemm g{(const bf16*)(ws + WS_XN), (const bf16*)(ws + WS_WIN), M, NIN, DM}; pg8::StaticOrder S; S.init(M, NIN, G, (int)blockIdx.x);
        pg8::EpiProj E{(bf16*)(ws + WS_PROJ), NIN};
        pg8::gemm_phase<pg8::EpiProj, pg8::StaticOrder, true, true>(lds, g, S, E);
    }
    SEAM(1);
    if (IN(2)) { for (int it = gw; it < NSUP * NG; it += NGW) ssm_pass1(args, it, lane); }
    SEAM(2);
    if (IN(3)) {
        for (int it = gw; it < NCHUNK * NG; it += NGW) ssm_pass2(args, it, lane, lds + wave * 16384);
        for (int it = blockIdx.x * NTHREADS + tid; it < (M / 8) * (DC / 8); it += G * NTHREADS) conv_item(args, it);
        __syncthreads();
    }
    SEAM(3);
    if (IN(4)) {
        pg8::Gemm g{(const bf16*)(ws + WS_YG), (const bf16*)(ws + WS_WGLU), M, DS, DS}; pg8::StaticOrder S; S.init(M, DS, G, (int)blockIdx.x);
        pg8::EpiGlu E{(const bf16*)(ws + WS_YG), (const bf16*)(ws + WS_PROJ) + 5 * DC, NIN, args.in[14], (bf16*)(ws + WS_MIX) + DC, DMIX};
        pg8::gemm_phase<pg8::EpiGlu, pg8::StaticOrder, false, true>(lds, g, S, E);
    }
    SEAM(4);
    if (IN(5)) {
        pg8::Gemm g{(const bf16*)(ws + WS_MIX), (const bf16*)(ws + WS_WOUT), M, DM, DMIX}; pg8::StaticOrder S; S.init(M, DM, G, (int)blockIdx.x);
        pg8::EpiOut E{args.out, DM, (float*)(ws + WS_SSQ)};
        pg8::gemm_phase<pg8::EpiOut, pg8::StaticOrder, false, true>(lds, g, S, E);
    }
    SEAM(5);
    if (IN(6)) { for (int m = gw; m < M; m += NGW) final_row(args, m, lane); }
#undef IN
#undef SEAM
}

#ifndef MK_N_LAUNCHES
#define MK_N_LAUNCHES 1
#endif
constexpr int N_PHASES = 7;
extern "C" void kernel_launch(void* const* d_in, const int* in_sizes, int n_in, void* d_out, int out_size, void* d_ws, size_t ws_size, hipStream_t stream) {
    static int grid = 0;
    if (grid == 0) {
        if (n_in != 17 || out_size != M * DM || ws_size < WS_END) { fprintf(stderr, "kernel_launch: unexpected shapes (n_in %d, out %d, ws %zu)\n", n_in, out_size, ws_size); grid = -1; return; }
        int dev = 0, cus = 0, per_cu = 0;
        if (hipGetDevice(&dev) != hipSuccess || hipDeviceGetAttribute(&cus, hipDeviceAttributeMultiprocessorCount, dev) != hipSuccess) { grid = -1; return; }
        if (hipFuncSetAttribute((const void*)fwd_kernel, hipFuncAttributeMaxDynamicSharedMemorySize, LDS_BYTES) != hipSuccess) { fprintf(stderr, "kernel_launch: hipFuncSetAttribute failed\n"); grid = -1; return; }
        if (hipOccupancyMaxActiveBlocksPerMultiprocessor(&per_cu, (const void*)fwd_kernel, NTHREADS, LDS_BYTES) != hipSuccess || per_cu < 1) { fprintf(stderr, "kernel_launch: occupancy query gave %d\n", per_cu); (void)hipGetLastError(); grid = -1; return; }
        grid = cus * per_cu;
    }
    if (grid < 0) return;
    Args a{};
    for (int i = 0; i < 17; ++i) a.in[i] = (const float*)d_in[i];
    a.out = (float*)d_out; a.ws = (unsigned char*)d_ws;
    if (MK_N_LAUNCHES == 1) {
        a.ph_lo = 0; a.ph_hi = N_PHASES;
        void* kargs[] = {&a};
        const hipError_t e = hipLaunchCooperativeKernel((const void*)fwd_kernel, dim3(grid), dim3(NTHREADS), kargs, LDS_BYTES, stream);
        if (e != hipSuccess) fprintf(stderr, "kernel_launch: cooperative launch failed: %s (grid %d)\n", hipGetErrorString(e), grid);
    } else {
        for (int p = 0; p < N_PHASES; ++p) { a.ph_lo = p; a.ph_hi = p + 1; hipLaunchKernelGGL(fwd_kernel, dim3(grid), dim3(NTHREADS), LDS_BYTES, stream, a); }
    }
}
```

```cpp
#include <hip/hip_runtime.h>
#include <hip/hip_cooperative_groups.h>
#include <cstdio>
#include <cstdint>
namespace cg = cooperative_groups;
namespace pg8 {
#define PG8_LAS __attribute__((address_space(3)))
typedef unsigned short bf16_t;
typedef short bf16x8 __attribute__((ext_vector_type(8)));
typedef float f32x4 __attribute__((ext_vector_type(4)));
typedef unsigned u32x4 __attribute__((ext_vector_type(4)));
constexpr int BM = 256, BK = 64, HALF = 128, HTB = HALF * BK * 2  , STAGE_BYTES = 8 * HTB, NXCD = 8, WGM = 8;

__host__ __device__ __forceinline__ int lds_byte(int r, int c) { const int st = (r >> 4) * 2 + (c >> 5), rr = r & 15, cc = c & 31, ob = rr * 64 + cc * 2; return st * 1024 + (ob ^ (((ob >> 9) & 1) << 5)); }
__host__ __device__ __forceinline__ void stage_rc(int b, int& R, int& C) { const int st = b / 1024, sb = b % 1024, swz = sb ^ (((sb >> 9) & 1) << 5); R = (st >> 1) * 16 + swz / 64; C = (st & 1) * 32 + (swz % 64) / 2; }
__host__ __device__ __forceinline__ int perm32(int rho) { const int n = rho >> 4, i = rho & 15; return 8 * (i >> 2) + 4 * n + (i & 3); }

struct Unit { int pm, pn; };
struct Gemm { const bf16_t* A; const bf16_t* Bt; int M, N, K; };

struct StaticOrder {
    int nM, nN, nwg, G, c;
    __host__ __device__ void init(int M, int N, int G_, int c_) { nM = M / BM; nN = N / BM; nwg = nM * nN; G = G_; c = c_; }
    __host__ __device__ bool next(int i, Unit& u) const {
        const long L = (long)i * G + c; if (L >= nwg) return false;
        int wgid = (int)L; { const int q = nwg / NXCD, r = nwg % NXCD, xcd = wgid % NXCD, off = wgid / NXCD; wgid = (xcd < r ? xcd * (q + 1) : r * (q + 1) + (xcd - r) * q) + off; }
        const int nig = WGM * nN, gid = wgid / nig, fm = gid * WGM, gsz = (nM - fm) < WGM ? (nM - fm) : WGM;
        u.pm = fm + ((wgid % nig) % gsz); u.pn = (wgid % nig) / gsz; return true;
    }
    __device__ __forceinline__ void a_ready(const Unit&) const {}
    __device__ __forceinline__ void done(const Unit&) const {}
};

__device__ __forceinline__ unsigned cvt_pk_bf16(float lo, float hi) { unsigned r; asm volatile("v_cvt_pk_bf16_f32 %0, %1, %2" : "=v"(r) : "v"(lo), "v"(hi)); return r; }
__device__ __forceinline__ float bf_lo(unsigned w) { return __uint_as_float(w << 16); }
__device__ __forceinline__ float bf_hi(unsigned w) { return __uint_as_float(w & 0xffff0000u); }
__device__ __forceinline__ float sigmoidf_(float v) { return 1.0f / (1.0f + __expf(-v)); }

struct EpiProj {
    static constexpr bool PERM = true, AFTER_DRAIN = false;
    bf16_t* O; int ldc;
    __device__ __forceinline__ void operator()(const f32x4 (&acc)[2][2][4][2], const Unit& u, int wr, int wc, int fr, int fq) const {
        const int row0 = u.pm * BM + wr * 64 + fr; const int col0 = u.pn * BM + wc * 32 + 8 * fq;
#pragma unroll
        for (int ai = 0; ai < 2; ++ai)
#pragma unroll
            for (int m = 0; m < 4; ++m) { bf16_t* rowp = O + (size_t)(row0 + ai * HALF + m * 16) * ldc + col0;
#pragma unroll
                for (int bj = 0; bj < 2; ++bj) { const f32x4 v0 = acc[ai][bj][m][0], v1 = acc[ai][bj][m][1];
                    u32x4 w; w.x = cvt_pk_bf16(v0[0], v0[1]); w.y = cvt_pk_bf16(v0[2], v0[3]); w.z = cvt_pk_bf16(v1[0], v1[1]); w.w = cvt_pk_bf16(v1[2], v1[3]);
                    *(u32x4*)(rowp + bj * HALF) = w; } }
    }
};
struct EpiGlu {
    static constexpr bool PERM = true, AFTER_DRAIN = false;
    const bf16_t* YG; const bf16_t* Z; int ldz; const float* bias; bf16_t* O; int ldo;
    __device__ __forceinline__ void operator()(const f32x4 (&acc)[2][2][4][2], const Unit& u, int wr, int wc, int fr, int fq) const {
        const int row0 = u.pm * BM + wr * 64 + fr; const int col0 = u.pn * BM + wc * 32 + 8 * fq;
        f32x4 bv[2][2];
#pragma unroll
        for (int bj = 0; bj < 2; ++bj)
#pragma unroll
            for (int n = 0; n < 2; ++n) bv[bj][n] = *(const f32x4*)(bias + col0 + bj * HALF + 4 * n);
#pragma unroll
        for (int ai = 0; ai < 2; ++ai)
#pragma unroll
            for (int m = 0; m < 4; ++m) { const size_t row = (size_t)(row0 + ai * HALF + m * 16);
#pragma unroll
                for (int bj = 0; bj < 2; ++bj) { const int c = col0 + bj * HALF;
                    const u32x4 yw = *(const u32x4*)(YG + row * 1024 + c); const u32x4 zw = *(const u32x4*)(Z + row * ldz + c);
                    const f32x4 g0 = acc[ai][bj][m][0] + bv[bj][0], g1 = acc[ai][bj][m][1] + bv[bj][1];
                    float o[8]; const float gg[8] = {g0[0], g0[1], g0[2], g0[3], g1[0], g1[1], g1[2], g1[3]};
                    const unsigned yy[4] = {yw.x, yw.y, yw.z, yw.w}, zz[4] = {zw.x, zw.y, zw.z, zw.w};
#pragma unroll
                    for (int e = 0; e < 4; ++e) { const float y0 = bf_lo(yy[e]), y1 = bf_hi(yy[e]), z0 = bf_lo(zz[e]), z1 = bf_hi(zz[e]);
                        o[2 * e] = y0 * sigmoidf_(gg[2 * e]) * (z0 * sigmoidf_(z0)); o[2 * e + 1] = y1 * sigmoidf_(gg[2 * e + 1]) * (z1 * sigmoidf_(z1)); }
                    u32x4 w; w.x = cvt_pk_bf16(o[0], o[1]); w.y = cvt_pk_bf16(o[2], o[3]); w.z = cvt_pk_bf16(o[4], o[5]); w.w = cvt_pk_bf16(o[6], o[7]);
                    *(u32x4*)(O + row * ldo + c) = w; } }
    }
};
struct EpiOut {
    static constexpr bool PERM = false, AFTER_DRAIN = false;
    float* O; int ldc; float* SSQ;
    __device__ __forceinline__ void operator()(const f32x4 (&acc)[2][2][4][2], const Unit& u, int wr, int wc, int fr, int fq) const {
        const int row0 = u.pm * BM + wr * 64 + fr; const int col0 = u.pn * BM + wc * 32 + 4 * fq;
#pragma unroll
        for (int ai = 0; ai < 2; ++ai)
#pragma unroll
            for (int m = 0; m < 4; ++m) { const size_t row = (size_t)(row0 + ai * HALF + m * 16); float s = 0.f;
#pragma unroll
                for (int bj = 0; bj < 2; ++bj)
#pragma unroll
                    for (int n = 0; n < 2; ++n) { const f32x4 v = acc[ai][bj][m][n]; s += (v[0] * v[0] + v[1] * v[1]) + (v[2] * v[2] + v[3] * v[3]);
                        *(f32x4*)(O + row * ldc + col0 + bj * HALF + n * 16) = v; }
                s += __shfl_xor(s, 16); s += __shfl_xor(s, 32);
                if (fq == 0) SSQ[row * 32 + u.pn * 4 + wc] = s; }
    }
};

template <class Epi, class Sched, bool ALIGN_EPI = false, bool SP2 = false>
__device__ __forceinline__ void gemm_phase(PG8_LAS unsigned char* lds, const Gemm g, const Sched& S, const Epi& E) {
    const int tid = threadIdx.x, wid = __builtin_amdgcn_readfirstlane(tid >> 6), lane = tid & 63, wr = wid >> 2, wc = wid & 3, fr = lane & 15, fq = lane >> 4;
    const int K = g.K, nt = K / BK;
    unsigned voffA[2], voffB[2];
#pragma unroll
    for (int i = 0; i < 2; ++i) { int R, C; stage_rc(tid * 16 + i * 8192, R, C); const int Rb = Epi::PERM ? ((R & ~31) + perm32(R & 31)) : R;
        voffA[i] = (unsigned)(R * K + C) * 2u; voffB[i] = (unsigned)(Rb * K + C) * 2u; }
    const size_t kstep = (size_t)(BK * 2);
    const size_t hstep = (size_t)HALF * K * 2;
    const size_t tstep = 2 * hstep;
    const unsigned ldsw = (unsigned)wid * 1024u;
    const int aoff = lds_byte(wr * 64 + fr, fq * 8), boff = lds_byte(wc * 32 + fr, fq * 8);
#define PG8_SA(b, h) (((b) * 2 + (h)) * HTB)
#define PG8_SB(b, h) ((4 + (b) * 2 + (h)) * HTB)
#define PG8_STAGE(bufoff, gbase, voff) do { _Pragma("unroll") for (int _i = 0; _i < 2; ++_i) \
        __builtin_amdgcn_global_load_lds((const unsigned*)((const char*)(gbase) + (voff)[_i]), (PG8_LAS unsigned*)(lds + (bufoff) + ldsw + _i * 8192), 16, 0, 0); } while (0)
#define PG8_LDA(dst, b, h) do { _Pragma("unroll") for (int m = 0; m < 4; ++m) _Pragma("unroll") for (int k = 0; k < 2; ++k) dst[m][k] = *(const PG8_LAS bf16x8*)(lds + PG8_SA(b, h) + aoff + m * 2048 + k * 1024); } while (0)
#define PG8_LDB(dst, b, h) do { _Pragma("unroll") for (int n = 0; n < 2; ++n) _Pragma("unroll") for (int k = 0; k < 2; ++k) dst[n][k] = *(const PG8_LAS bf16x8*)(lds + PG8_SB(b, h) + boff + n * 2048 + k * 1024); } while (0)
#define PG8_MMA(ai, bj, At, Bt) do { __builtin_amdgcn_s_setprio(1); _Pragma("unroll") for (int m = 0; m < 4; ++m) _Pragma("unroll") for (int n = 0; n < 2; ++n) _Pragma("unroll") for (int k = 0; k < 2; ++k) \
        acc[ai][bj][m][n] = __builtin_amdgcn_mfma_f32_16x16x32_bf16(Bt[n][k], At[m][k], acc[ai][bj][m][n], 0, 0, 0); __builtin_amdgcn_s_setprio(0); } while (0)
#define PG8_WAIT_V(n) asm volatile("s_waitcnt vmcnt(" #n ")" ::: "memory")
#define PG8_WAIT_L(n) asm volatile("s_waitcnt lgkmcnt(" #n ")" ::: "memory")
#define PG8_BAR __builtin_amdgcn_s_barrier()
#define PG8_SCHED __builtin_amdgcn_sched_barrier(0)
    Unit cur, nxt; int ui = 0;
    if (!S.next(0, cur)) return;
    f32x4 acc[2][2][4][2];
#pragma unroll
    for (int a = 0; a < 2; ++a)
#pragma unroll
        for (int b = 0; b < 2; ++b)
#pragma unroll
            for (int m = 0; m < 4; ++m)
#pragma unroll
                for (int n = 0; n < 2; ++n) acc[a][b][m][n] = (f32x4){0.f, 0.f, 0.f, 0.f};
    bf16x8 At[4][2], B0[2][2], B1[2][2];
    const char* cA = (const char*)g.A + (size_t)cur.pm * tstep; const char* cB = (const char*)g.Bt + (size_t)cur.pn * tstep;
    S.a_ready(cur);
    if constexpr (SP2) {
        PG8_STAGE(PG8_SB(0, 0), cB, voffB); PG8_STAGE(PG8_SB(0, 1), cB + hstep, voffB); PG8_STAGE(PG8_SA(0, 0), cA, voffA); PG8_STAGE(PG8_SA(0, 1), cA + hstep, voffA);
        if (wr == 1) PG8_BAR;
        PG8_WAIT_V(2); PG8_BAR;
        PG8_STAGE(PG8_SB(1, 0), cB + kstep, voffB); PG8_STAGE(PG8_SA(1, 0), cA + kstep, voffA); PG8_STAGE(PG8_SB(1, 1), cB + hstep + kstep, voffB);
        PG8_WAIT_V(6); PG8_BAR;
    } else {
        PG8_STAGE(PG8_SB(0, 0), cB, voffB); PG8_STAGE(PG8_SA(0, 0), cA, voffA); PG8_STAGE(PG8_SB(0, 1), cB + hstep, voffB); PG8_STAGE(PG8_SA(0, 1), cA + hstep, voffA);
        if (wr == 1) PG8_BAR;
        PG8_WAIT_V(4); PG8_BAR;
        PG8_STAGE(PG8_SB(1, 0), cB + kstep, voffB); PG8_STAGE(PG8_SA(1, 0), cA + kstep, voffA); PG8_STAGE(PG8_SB(1, 1), cB + hstep + kstep, voffB);
        PG8_WAIT_V(6); PG8_BAR;
    }
    for (;;) {
        const bool has_next = S.next(ui + 1, nxt);
        const char* nA = has_next ? (const char*)g.A + (size_t)nxt.pm * tstep : cA; const char* nB = has_next ? (const char*)g.Bt + (size_t)nxt.pn * tstep : cB;
        for (int t = 0; t < nt; t += 2) {
            const bool last = (t == nt - 2);
            const char* a1 = cA + (size_t)(t + 1) * kstep;
            const char* a2 = last ? nA : cA + (size_t)(t + 2) * kstep; const char* b2 = last ? nB : cB + (size_t)(t + 2) * kstep;
            const char* a3 = a2 + kstep; const char* b3 = b2 + kstep;
            if (last && has_next) S.a_ready(nxt);
            if constexpr (SP2) {
            PG8_LDB(B0, 0, 0); PG8_LDB(B1, 0, 1); PG8_SCHED; PG8_LDA(At, 0, 0); PG8_STAGE(PG8_SA(1, 1), a1 + hstep, voffA);
            PG8_WAIT_V(8); PG8_WAIT_L(0); PG8_BAR; PG8_MMA(0, 0, At, B0); PG8_MMA(0, 1, At, B1); PG8_BAR; PG8_SCHED;
            PG8_LDA(At, 0, 1); PG8_STAGE(PG8_SB(0, 0), b2, voffB); PG8_STAGE(PG8_SB(0, 1), b2 + hstep, voffB); PG8_STAGE(PG8_SA(0, 0), a2, voffA);
            PG8_WAIT_V(8); PG8_WAIT_L(0); PG8_BAR; PG8_MMA(1, 0, At, B0); PG8_MMA(1, 1, At, B1); PG8_BAR; PG8_SCHED;
            PG8_LDB(B0, 1, 0); PG8_LDB(B1, 1, 1); PG8_SCHED; PG8_LDA(At, 1, 0); PG8_STAGE(PG8_SA(0, 1), a2 + hstep, voffA);
            PG8_WAIT_V(8); PG8_WAIT_L(0); PG8_BAR; PG8_MMA(0, 0, At, B0); PG8_MMA(0, 1, At, B1); PG8_BAR; PG8_SCHED;
            PG8_LDA(At, 1, 1); PG8_STAGE(PG8_SB(1, 0), b3, voffB); PG8_STAGE(PG8_SB(1, 1), b3 + hstep, voffB); PG8_STAGE(PG8_SA(1, 0), a3, voffA);
            PG8_WAIT_V(8); PG8_WAIT_L(0); PG8_BAR; PG8_MMA(1, 0, At, B0); PG8_MMA(1, 1, At, B1); PG8_BAR; PG8_SCHED;
            } else {
            PG8_LDB(B0, 0, 0); PG8_SCHED; PG8_LDA(At, 0, 0); PG8_STAGE(PG8_SA(1, 1), a1 + hstep, voffA);
            PG8_WAIT_L(8); PG8_BAR; PG8_WAIT_L(0); PG8_MMA(0, 0, At, B0); PG8_BAR; PG8_SCHED;
            PG8_LDB(B1, 0, 1); PG8_STAGE(PG8_SB(0, 0), b2, voffB);
            PG8_BAR; PG8_WAIT_L(0); PG8_MMA(0, 1, At, B1); PG8_BAR;
            PG8_LDA(At, 0, 1); PG8_STAGE(PG8_SA(0, 0), a2, voffA);
            PG8_BAR; PG8_WAIT_L(0); PG8_MMA(1, 0, At, B0); PG8_BAR; PG8_SCHED;
            PG8_STAGE(PG8_SB(0, 1), b2 + hstep, voffB);
            PG8_WAIT_V(6); PG8_BAR; PG8_MMA(1, 1, At, B1); PG8_BAR;
            PG8_LDB(B0, 1, 0); PG8_SCHED; PG8_LDA(At, 1, 0); PG8_STAGE(PG8_SA(0, 1), a2 + hstep, voffA);
            PG8_WAIT_L(8); PG8_BAR; PG8_WAIT_L(0); PG8_MMA(0, 0, At, B0); PG8_BAR; PG8_SCHED;
            PG8_LDB(B1, 1, 1); PG8_STAGE(PG8_SB(1, 0), b3, voffB);
            PG8_BAR; PG8_WAIT_L(0); PG8_MMA(0, 1, At, B1); PG8_BAR;
            PG8_LDA(At, 1, 1); PG8_STAGE(PG8_SA(1, 0), a3, voffA);
            PG8_BAR; PG8_WAIT_L(0); PG8_MMA(1, 0, At, B0); PG8_BAR; PG8_SCHED;
            PG8_STAGE(PG8_SB(1, 1), b3 + hstep, voffB);
            PG8_WAIT_V(6); PG8_BAR; PG8_MMA(1, 1, At, B1); PG8_BAR;
            }
        }
        if constexpr (ALIGN_EPI) { if (wr == 0) PG8_BAR; }
        if constexpr (!Epi::AFTER_DRAIN) { E(acc, cur, wr, wc, fr, fq); S.done(cur); }
        if (!has_next) break;
#pragma unroll
        for (int a = 0; a < 2; ++a)
#pragma unroll
            for (int b = 0; b < 2; ++b)
#pragma unroll
                for (int m = 0; m < 4; ++m)
#pragma unroll
                    for (int n = 0; n < 2; ++n) acc[a][b][m][n] = (f32x4){0.f, 0.f, 0.f, 0.f};
        cur = nxt; cA = nA; cB = nB; ++ui;
        if constexpr (ALIGN_EPI) { if (wr == 1) PG8_BAR; }
    }
    PG8_WAIT_V(0);
    if constexpr (!ALIGN_EPI) { if (wr == 0) PG8_BAR; }
    PG8_BAR;
    if constexpr (Epi::AFTER_DRAIN) { E.fused(acc, cur, wr, wc, fr, fq, lds, wid, lane); S.done(cur); }
#undef PG8_SA
#undef PG8_SB
#undef PG8_STAGE
#undef PG8_LDA
#undef PG8_LDB
#undef PG8_MMA
#undef PG8_WAIT_V
#undef PG8_WAIT_L
#undef PG8_BAR
#undef PG8_SCHED
}
}
constexpr int NWAVES = 8, NTHREADS = NWAVES * 64;
constexpr int BATCH = 2, SEQ = 4096, DM = 2048, M = BATCH * SEQ, NIN = 6144, DC = 1024, DS = 1024, DMIX = 2048;
constexpr int NG = 64, NP = 64, NH = 16;
constexpr int CH = 64, NCHUNK = M / CH;
constexpr int SUP = 8, NSUP = NCHUNK / SUP;
constexpr float EPS = 1e-6f;
constexpr size_t MiB = 1u << 20;
constexpr size_t WS_CTL = 0, CTL_ZERO_BYTES = 65536;
constexpr size_t WS_WIN = 1 * MiB, WS_WGLU = 25 * MiB, WS_WOUT = 27 * MiB, WS_XN = 35 * MiB, WS_PROJ = 67 * MiB, WS_YG = 163 * MiB, WS_MIX = 179 * MiB;
constexpr size_t WS_SSQ = 211 * MiB, WS_CS = 212 * MiB  , WS_ES = 216 * MiB  , WS_APOW = 217 * MiB  ;
constexpr size_t WS_BBAR = 218 * MiB  , WS_CMAT = 219 * MiB  , WS_END = 220 * MiB;
constexpr int RING_BYTES = 131072, LDS_BYTES = RING_BYTES + 1024;

#define GAS __attribute__((address_space(1)))
#define LAS __attribute__((address_space(3)))
typedef unsigned short bf16;
typedef unsigned v4u __attribute__((ext_vector_type(4)));
typedef unsigned v2u __attribute__((ext_vector_type(2)));
typedef float f32x4 __attribute__((ext_vector_type(4)));
typedef float f32x2 __attribute__((ext_vector_type(2)));
typedef float f32x16 __attribute__((ext_vector_type(16)));
typedef short bf16x8 __attribute__((ext_vector_type(8)));
#define LDS_WAIT() asm volatile("s_waitcnt lgkmcnt(0)" ::: "memory")
__device__ __forceinline__ unsigned f2bf(float f) { unsigned u = __builtin_bit_cast(unsigned, f); return (u + 0x7fffu + ((u >> 16) & 1u)) >> 16; }
__device__ __forceinline__ unsigned pk2(float lo, float hi) { return f2bf(lo) | (f2bf(hi) << 16); }
__device__ __forceinline__ float bf2f(bf16 h) { return __uint_as_float((unsigned)h << 16); }
using pg8::cvt_pk_bf16; using pg8::bf_lo; using pg8::bf_hi; using pg8::sigmoidf_;

#define RLX_AGENT __ATOMIC_RELAXED, __HIP_MEMORY_SCOPE_AGENT
#define XB_TMO      128
#define XB_XCNT(j)  (256  + 64 * (j))
#define XB_XSUB(j)  (1280 + 64 * (j))
#define XB_XGEN(j)  (2304 + 64 * (j))
#define XB_TOP      3328
#define XB_TOPGEN   3392
#define XCD_BAR_WORDS 3456
#define XB_SPIN_CAP (1u << 18)

__device__ __forceinline__ unsigned xb_ld(unsigned* p)              { return __hip_atomic_load(p, __ATOMIC_RELAXED, __HIP_MEMORY_SCOPE_AGENT); }
__device__ __forceinline__ unsigned xb_add(unsigned* p, unsigned v) { return __hip_atomic_fetch_add(p, v, __ATOMIC_RELAXED, __HIP_MEMORY_SCOPE_AGENT); }
__device__ __forceinline__ unsigned xb_xcc_id() { return (unsigned)__builtin_amdgcn_s_getreg((3 << 11) | 20) & 0xFu; }
#define XB_SPIN(cond, bar) do { unsigned _sp = 0; while (cond) { __builtin_amdgcn_s_sleep(1); \
    if ((++_sp & 255u) == 0u) { if (xb_ld(&(bar)[XB_TMO])) break; if (_sp > XB_SPIN_CAP) { atomicAdd(&(bar)[XB_TMO], 1u); break; } } } } while (0)

struct XcdBarrier {
    unsigned* bar; unsigned x;
    volatile LAS unsigned* st;
};

__device__ __forceinline__ XcdBarrier xcd_barrier_post(unsigned* bar, volatile LAS unsigned* st) {
    XcdBarrier b; b.bar = bar; b.x = xb_xcc_id(); b.st = st;
    if (threadIdx.x == 0) (void)xb_add(&bar[XB_XCNT(b.x)], 1u);
    return b;
}
__device__ __forceinline__ void xcd_barrier_complete(unsigned* bar, unsigned x, unsigned& nloc, unsigned& nx) {
    const unsigned G = gridDim.x * gridDim.y * gridDim.z;
    unsigned sum, cnt, mine, sp = 0u;
    for (;;) {
        sum = 0u; cnt = 0u; mine = 0u;
#pragma unroll
        for (unsigned j = 0; j < 16; ++j) { const unsigned c = xb_ld(&bar[XB_XCNT(j)]); sum += c; cnt += (c > 0u) ? 1u : 0u; mine = (j == x) ? c : mine; }
        if (sum == G) break;
        __builtin_amdgcn_s_sleep(1);
        if ((++sp & 255u) == 0u) { if (xb_ld(&bar[XB_TMO])) break; if (sp > XB_SPIN_CAP) { atomicAdd(&bar[XB_TMO], 1u); break; } }
    }
    nloc = mine > 0u ? mine : 1u; nx = cnt > 0u ? cnt : 1u;
}

__device__ __forceinline__ void xcd_barrier(const XcdBarrier& b) {
    asm volatile("s_waitcnt vmcnt(0)" ::: "memory");
    __syncthreads();
    if (threadIdx.x == 0) {
        unsigned* bar = b.bar;
        __builtin_amdgcn_s_waitcnt(0);
        unsigned nloc = b.st[0], nx = b.st[1];
        if (nloc == 0u) { xcd_barrier_complete(bar, b.x, nloc, nx); b.st[0] = nloc; b.st[1] = nx; }
        const unsigned old = xb_add(&bar[XB_XSUB(b.x)], 1u);
        const unsigned gen = old / nloc;
        if (old + 1u == (gen + 1u) * nloc) {
            __builtin_amdgcn_fence(__ATOMIC_RELEASE, "agent");
            asm volatile("s_waitcnt vmcnt(0)" ::: "memory");
            const unsigned og = xb_add(&bar[XB_TOP], 1u);
            const unsigned tg = og / nx;
            if (og + 1u == (tg + 1u) * nx) xb_add(&bar[XB_TOPGEN], 1u);
            else XB_SPIN(xb_ld(&bar[XB_TOPGEN]) == tg, bar);
            __builtin_amdgcn_fence(__ATOMIC_ACQUIRE, "agent");
            xb_add(&bar[XB_XGEN(b.x)], 1u);
            asm volatile("s_waitcnt vmcnt(0)" ::: "memory");
        } else {
            XB_SPIN(xb_ld(&bar[XB_XGEN(b.x)]) == gen, bar);
            __builtin_amdgcn_fence(__ATOMIC_ACQUIRE, "agent");
            asm volatile("s_waitcnt vmcnt(0)" ::: "memory");
        }
    }
    __syncthreads();
}

struct Args { const float* in[17]; float* out; unsigned char* ws; int ph_lo, ph_hi; };

__device__ __forceinline__ float wave_sum(float v) {
#pragma unroll
    for (int o = 1; o < 64; o <<= 1) v += __shfl_xor(v, o);
    return v;
}
__device__ __forceinline__ void p0_transpose_item(const float* W, int K, int N, bf16* WT, LAS float* scr, int item, int lane) {
    const int nblk = N / 32, kb = item / nblk, nb = item % nblk, k0 = 64 * kb, n0 = 32 * nb;
#pragma unroll 8
    for (int i = 0; i < 32; ++i) { const int kk = 2 * i + (lane >> 5); scr[kk * 33 + (lane & 31)] = W[(size_t)(k0 + kk) * N + n0 + (lane & 31)]; }
    LDS_WAIT(); asm volatile("" ::: "memory");
    const int c = lane & 7;
#pragma unroll
    for (int j = 0; j < 4; ++j) { const int n = (lane >> 3) + 8 * j; const LAS float* s = scr + (8 * c) * 33 + n;
        v4u o; o.x = pk2(s[0 * 33], s[1 * 33]); o.y = pk2(s[2 * 33], s[3 * 33]); o.z = pk2(s[4 * 33], s[5 * 33]); o.w = pk2(s[6 * 33], s[7 * 33]);
        *(GAS v4u*)(WT + (size_t)(n0 + n) * K + k0 + 8 * c) = o; }
    LDS_WAIT(); asm volatile("" ::: "memory");
}
__device__ __forceinline__ void rms_row_to_bf16(const float* xrow, const float* g, bf16* orow, int lane) {
    const GAS f32x4* xr = (const GAS f32x4*)xrow + lane; const GAS f32x4* gr = (const GAS f32x4*)g + lane;
    f32x4 v[8]; float s = 0.f;
#pragma unroll
    for (int j = 0; j < 8; ++j) { v[j] = xr[64 * j]; s += (v[j].x * v[j].x + v[j].y * v[j].y) + (v[j].z * v[j].z + v[j].w * v[j].w); }
    const float rs = 1.0f / sqrtf(wave_sum(s) * (1.f / DM) + EPS);
    GAS v2u* o8 = (GAS v2u*)orow + lane;
#pragma unroll
    for (int j = 0; j < 8; ++j) { const f32x4 gg = gr[64 * j]; v2u o; o.x = cvt_pk_bf16(v[j].x * rs * gg.x, v[j].y * rs * gg.y); o.y = cvt_pk_bf16(v[j].z * rs * gg.z, v[j].w * rs * gg.w); o8[64 * j] = o; }
}
__device__ __forceinline__ void sincos_f64(float ang, float& s, float& c) {
    const double x = (double)ang, TWO_PI = 6.283185307179586476925; const double k = rint(x / TWO_PI); const double r = x - k * TWO_PI, r2 = r * r;
    double a = 1.0, b = 1.0;
#pragma unroll
    for (int n = 14; n >= 1; --n) { a = 1.0 - a * r2 / (double)((2 * n) * (2 * n + 1)); b = 1.0 - b * r2 / (double)((2 * n - 1) * (2 * n)); }
    s = (float)(r * a); c = (float)b;
}
__device__ __forceinline__ void cmul(float& xr, float& xi, float yr, float yi) { const float r = xr * yr - xi * yi, i = xr * yi + xi * yr; xr = r; xi = i; }
__device__ __forceinline__ void p0_ssm_params(const Args& a, int gp) {
    const int g = gp >> 6, p = gp & 63;
    const float lr = a.in[5][gp], li = a.in[6][gp], dt = expf(a.in[7][g]);
    const float mag = expf(lr * dt); float sn, cs; sincos_f64(li * dt, sn, cs);
    const float lbr = mag * cs, lbi = mag * sn;
    const float nr = lbr - 1.0f, ni = lbi, den = lr * lr + li * li;
    const float qr = (nr * lr + ni * li) / den, qi = (ni * lr - nr * li) / den;
    float* ap = (float*)(a.ws + WS_APOW) + (size_t)gp * 12;
    float pr = lbr, pi = lbi; ap[0] = pr; ap[1] = pi;
    cmul(pr, pi, lbr, lbi); ap[2] = pr; ap[3] = pi;
    cmul(pr, pi, lbr, lbi); ap[4] = pr; ap[5] = pi;
    cmul(pr, pi, lbr, lbi); ap[6] = pr; ap[7] = pi;
#pragma unroll
    for (int i = 0; i < 4; ++i) cmul(pr, pi, pr, pi);
    ap[8] = pr; ap[9] = pi;
#pragma unroll
    for (int i = 0; i < 3; ++i) cmul(pr, pi, pr, pi);
    ap[10] = pr; ap[11] = pi;
    bf16* BB = (bf16*)(a.ws + WS_BBAR); bf16* CM = (bf16*)(a.ws + WS_CMAT);
    const float* bre = a.in[8] + (size_t)gp * NH; const float* bim = a.in[9] + (size_t)gp * NH;
    const int nb0 = 2 * (p >> 5), col = p & 31;
    for (int h = 0; h < NH; ++h) {
        const float br = bre[h], bi = bim[h];
        const float bbr = qr * br - qi * bi, bbi = qr * bi + qi * br;
        const int lane = (h >> 3) * 32 + col, j = h & 7;
        BB[((size_t)(g * 4 + nb0) * 64 + lane) * 8 + j] = (bf16)f2bf(bbr);
        BB[((size_t)(g * 4 + nb0 + 1) * 64 + lane) * 8 + j] = (bf16)f2bf(bbi);
        const float cr = a.in[10][((size_t)g * NH + h) * NP + p], ci = a.in[11][((size_t)g * NH + h) * NP + p];
        const int kre = 4 * (p & 31) + 2 * (p >> 5), kim = kre + 1;
        { const int kk = kre >> 5, l2 = ((kre & 31) >> 3) * 16 + h, j2 = kre & 7; CM[((size_t)(g * 4 + kk) * 64 + l2) * 8 + j2] = (bf16)f2bf(cr); }
        { const int kk = kim >> 5, l2 = ((kim & 31) >> 3) * 16 + h, j2 = kim & 7; CM[((size_t)(g * 4 + kk) * 64 + l2) * 8 + j2] = (bf16)f2bf(-ci); }
    }
}

__device__ __forceinline__ void ssm_chunk(f32x16 (&acc)[2][4], const bf16x8 (&ua)[2], const bf16x8 (&bb)[4], const float (&ar)[2][4], const float (&ai)[2][4], float (&cr)[2], float (&ci)[2], int hf) {
    const f32x16 zero = {0.f, 0.f, 0.f, 0.f, 0.f, 0.f, 0.f, 0.f, 0.f, 0.f, 0.f, 0.f, 0.f, 0.f, 0.f, 0.f};
#pragma unroll
    for (int tb = 0; tb < 2; ++tb)
#pragma unroll
        for (int nb = 0; nb < 4; ++nb) acc[tb][nb] = __builtin_amdgcn_mfma_f32_32x32x16_bf16(ua[tb], bb[nb], zero, 0, 0, 0);
#pragma unroll
    for (int st = 0; st < 2; ++st) {
        const float a1r = ar[st][0], a1i = ai[st][0];
        float er[8], ei[8];
#pragma unroll
        for (int tb = 0; tb < 2; ++tb)
#pragma unroll
            for (int q = 0; q < 4; ++q) {
                float pr = acc[tb][2 * st][4 * q], pi = acc[tb][2 * st + 1][4 * q];
#pragma unroll
                for (int i = 1; i < 4; ++i) {
                    const float nr = acc[tb][2 * st][4 * q + i] + (a1r * pr - a1i * pi), ni = acc[tb][2 * st + 1][4 * q + i] + (a1r * pi + a1i * pr);
                    acc[tb][2 * st][4 * q + i] = nr; acc[tb][2 * st + 1][4 * q + i] = ni; pr = nr; pi = ni;
                }
                er[tb * 4 + q] = pr; ei[tb * 4 + q] = pi;
            }
        float c_r = cr[st], c_i = ci[st]; const float a4r = ar[st][3], a4i = ai[st][3];
        float mr[8], mi[8];
#pragma unroll
        for (int n8 = 0; n8 < 8; ++n8) {
            const float eor = __shfl_xor(er[n8], 32), eoi = __shfl_xor(ei[n8], 32);
            const float e0r = hf ? eor : er[n8], e0i = hf ? eoi : ei[n8], e1r = hf ? er[n8] : eor, e1i = hf ? ei[n8] : eoi;
            const float cer = c_r, cei = c_i;
            float tr = a4r * c_r - a4i * c_i + e0r, ti = a4r * c_i + a4i * c_r + e0i;
            const float cor = tr, coi = ti;
            c_r = a4r * tr - a4i * ti + e1r; c_i = a4r * ti + a4i * tr + e1i;
            mr[n8] = hf ? cor : cer; mi[n8] = hf ? coi : cei;
        }
        cr[st] = c_r; ci[st] = c_i;
#pragma unroll
        for (int tb = 0; tb < 2; ++tb)
#pragma unroll
            for (int q = 0; q < 4; ++q)
#pragma unroll
                for (int i = 0; i < 4; ++i) {
                    const float wr_ = ar[st][i], wi_ = ai[st][i], xr = mr[tb * 4 + q], xi = mi[tb * 4 + q];
                    acc[tb][2 * st][4 * q + i] += wr_ * xr - wi_ * xi; acc[tb][2 * st + 1][4 * q + i] += wr_ * xi + wi_ * xr;
                }
    }
}
__device__ __forceinline__ void ssm_load_consts(const Args& a, int g, int lane, bf16x8 (&bb)[4], float (&ar)[2][4], float (&ai)[2][4], float (&a64r)[2], float (&a64i)[2], float (&a512r)[2], float (&a512i)[2]) {
    const bf16x8* BB = (const bf16x8*)(a.ws + WS_BBAR);
#pragma unroll
    for (int nb = 0; nb < 4; ++nb) bb[nb] = BB[(size_t)(g * 4 + nb) * 64 + lane];
#pragma unroll
    for (int st = 0; st < 2; ++st) {
        const f32x4* ap = (const f32x4*)((const float*)(a.ws + WS_APOW) + (size_t)(g * 64 + st * 32 + (lane & 31)) * 12);
        const f32x4 v0 = ap[0], v1 = ap[1], v2 = ap[2];
        ar[st][0] = v0.x; ai[st][0] = v0.y; ar[st][1] = v0.z; ai[st][1] = v0.w; ar[st][2] = v1.x; ai[st][2] = v1.y; ar[st][3] = v1.z; ai[st][3] = v1.w;
        a64r[st] = v2.x; a64i[st] = v2.y; a512r[st] = v2.z; a512i[st] = v2.w;
    }
}
__device__ __forceinline__ void ssm_load_u(const bf16* PROJ, int chunk, int g, int lane, bf16x8 (&ua)[2]) {
#pragma unroll
    for (int tb = 0; tb < 2; ++tb) ua[tb] = *(const bf16x8*)(PROJ + (size_t)(chunk * CH + tb * 32 + (lane & 31)) * NIN + 4 * DC + g * NH + 8 * (lane >> 5));
}
__device__ __forceinline__ void ssm_pass1(const Args& a, int item, int lane) {
    const int sup = item >> 6, g = item & 63, hf = lane >> 5;
    const bf16* PROJ = (const bf16*)(a.ws + WS_PROJ);
    bf16x8 bb[4]; float ar[2][4], ai[2][4], a64r[2], a64i[2], a512r[2], a512i[2];
    ssm_load_consts(a, g, lane, bb, ar, ai, a64r, a64i, a512r, a512i);
    float cr[2] = {0.f, 0.f}, ci[2] = {0.f, 0.f};
    f32x2* CS = (f32x2*)(a.ws + WS_CS); f32x2* ES = (f32x2*)(a.ws + WS_ES);
    for (int k = 0; k < SUP; ++k) {
        const int chunk = sup * SUP + k;
        CS[(size_t)(chunk * NG + g) * NP + hf * 32 + (lane & 31)] = hf ? (f32x2){cr[1], ci[1]} : (f32x2){cr[0], ci[0]};
        bf16x8 ua[2]; ssm_load_u(PROJ, chunk, g, lane, ua);
        f32x16 acc[2][4];
        ssm_chunk(acc, ua, bb, ar, ai, cr, ci, hf);
    }
    ES[(size_t)(sup * NG + g) * NP + hf * 32 + (lane & 31)] = hf ? (f32x2){cr[1], ci[1]} : (f32x2){cr[0], ci[0]};
}
__device__ __forceinline__ float gelu_tanh(float v) {
    const float z = 0.7978845608028654f * (v + 0.044715f * v * v * v);
    const float t = 1.0f - 2.0f / (1.0f + __expf(2.0f * z));
    return 0.5f * v * (1.0f + t);
}
__device__ __forceinline__ void ssm_pass2(const Args& a, int item, int lane, LAS unsigned char* wl) {
    const int chunk = item >> 6, g = item & 63, hf = lane >> 5, j32 = lane & 31;
    const bf16* PROJ = (const bf16*)(a.ws + WS_PROJ);
    bf16x8 bb[4]; float ar[2][4], ai[2][4], a64r[2], a64i[2], a512r[2], a512i[2];
    ssm_load_consts(a, g, lane, bb, ar, ai, a64r, a64i, a512r, a512i);
    const f32x2* CS = (const f32x2*)(a.ws + WS_CS); const f32x2* ES = (const f32x2*)(a.ws + WS_ES);
    const int sup = chunk / SUP, kin = chunk % SUP, b = sup / (NSUP / BATCH), sb = sup % (NSUP / BATCH);
    float cr[2], ci[2];
#pragma unroll
    for (int st = 0; st < 2; ++st) {
        f32x2 es[7];
#pragma unroll
        for (int s = 0; s < 7; ++s) es[s] = (s < sb) ? ES[(size_t)((b * (NSUP / BATCH) + s) * NG + g) * NP + st * 32 + j32] : (f32x2){0.f, 0.f};
        float xr = 0.f, xi = 0.f;
#pragma unroll
        for (int s = 0; s < 7; ++s) if (s < sb) { const float tr = a512r[st] * xr - a512i[st] * xi + es[s].x, ti = a512r[st] * xi + a512i[st] * xr + es[s].y; xr = tr; xi = ti; }
        float pr = 1.f, pi = 0.f;
        for (int i = 0; i < kin; ++i) cmul(pr, pi, a64r[st], a64i[st]);
        const f32x2 c0 = CS[(size_t)(chunk * NG + g) * NP + st * 32 + j32];
        cr[st] = c0.x + pr * xr - pi * xi; ci[st] = c0.y + pr * xi + pi * xr;
    }
    bf16x8 ua[2]; ssm_load_u(PROJ, chunk, g, lane, ua);
    f32x16 acc[2][4];
    ssm_chunk(acc, ua, bb, ar, ai, cr, ci, hf);
    const bf16x8* CMp = (const bf16x8*)(a.ws + WS_CMAT);
    bf16x8 cm[4];
#pragma unroll
    for (int kk = 0; kk < 4; ++kk) cm[kk] = CMp[(size_t)(g * 4 + kk) * 64 + lane];
    const int chn = g * NH + (lane & 15); const float dsk = a.in[12][chn];
    bf16* YG = (bf16*)(a.ws + WS_YG);
    constexpr int ROWB = 272;
#pragma unroll
    for (int tb = 0; tb < 2; ++tb) {
#pragma unroll
        for (int r = 0; r < 16; ++r) { const int t = (r & 3) + 8 * (r >> 2) + 4 * hf;
            v2u w; w.x = cvt_pk_bf16(acc[tb][0][r], acc[tb][1][r]); w.y = cvt_pk_bf16(acc[tb][2][r], acc[tb][3][r]);
            *(LAS v2u*)(wl + t * ROWB + 8 * j32) = w; }
        LDS_WAIT();
#pragma unroll
        for (int t16 = 0; t16 < 2; ++t16) {
            f32x4 y = {0.f, 0.f, 0.f, 0.f};
#pragma unroll
            for (int kk = 0; kk < 4; ++kk) { const bf16x8 af = *(const LAS bf16x8*)(wl + (16 * t16 + (lane & 15)) * ROWB + (32 * kk + 8 * (lane >> 4)) * 2);
                y = __builtin_amdgcn_mfma_f32_16x16x32_bf16(af, cm[kk], y, 0, 0, 0); }
#pragma unroll
            for (int r = 0; r < 4; ++r) { const size_t token = (size_t)chunk * CH + 32 * tb + 16 * t16 + 4 * (lane >> 4) + r;
                const float u = bf2f(PROJ[token * NIN + 4 * DC + chn]);
                YG[token * DS + chn] = (bf16)f2bf(gelu_tanh(y[r] + dsk * u)); }
        }
        LDS_WAIT();
    }
}
__device__ __forceinline__ void conv_item(const Args& a, int item) {
    const int cg8 = item & 127, run = item >> 7, ch0 = cg8 * 8, t0 = run * 8;
    const bf16* PROJ = (const bf16*)(a.ws + WS_PROJ); bf16* MIX = (bf16*)(a.ws + WS_MIX);
    float w0[8], w1[8], w2[8], bs[8];
#pragma unroll
    for (int e = 0; e < 8; e += 4) { const f32x4 x0 = *(const f32x4*)(a.in[3] + ch0 + e), x1 = *(const f32x4*)(a.in[3] + DC + ch0 + e), x2 = *(const f32x4*)(a.in[3] + 2 * DC + ch0 + e), x3 = *(const f32x4*)(a.in[4] + ch0 + e);
#pragma unroll
        for (int q = 0; q < 4; ++q) { w0[e + q] = x0[q]; w1[e + q] = x1[q]; w2[e + q] = x2[q]; bs[e + q] = x3[q]; } }
    float p2[8], p1[8];
    if ((t0 % SEQ) == 0) {
#pragma unroll
        for (int e = 0; e < 8; ++e) { p2[e] = 0.f; p1[e] = 0.f; }
    } else {
        const v4u c2 = *(const v4u*)(PROJ + (size_t)(t0 - 2) * NIN + DC + ch0), v2 = *(const v4u*)(PROJ + (size_t)(t0 - 2) * NIN + 2 * DC + ch0);
        const v4u c1 = *(const v4u*)(PROJ + (size_t)(t0 - 1) * NIN + DC + ch0), v1 = *(const v4u*)(PROJ + (size_t)(t0 - 1) * NIN + 2 * DC + ch0);
#pragma unroll
        for (int e = 0; e < 4; ++e) { p2[2 * e] = bf_lo(c2[e]) * bf_lo(v2[e]); p2[2 * e + 1] = bf_hi(c2[e]) * bf_hi(v2[e]); p1[2 * e] = bf_lo(c1[e]) * bf_lo(v1[e]); p1[2 * e + 1] = bf_hi(c1[e]) * bf_hi(v1[e]); }
    }
#pragma unroll 2
    for (int i = 0; i < 8; ++i) {
        const bf16* row = PROJ + (size_t)(t0 + i) * NIN + ch0;
        const v4u bw = *(const v4u*)(row), cw = *(const v4u*)(row + DC), vw = *(const v4u*)(row + 2 * DC), zw = *(const v4u*)(row + 3 * DC);
        float o[8];
#pragma unroll
        for (int e = 0; e < 4; ++e) {
            const float cv0 = bf_lo(cw[e]) * bf_lo(vw[e]), cv1 = bf_hi(cw[e]) * bf_hi(vw[e]);
            const float k0 = bs[2 * e] + w0[2 * e] * p2[2 * e] + w1[2 * e] * p1[2 * e] + w2[2 * e] * cv0;
            const float k1 = bs[2 * e + 1] + w0[2 * e + 1] * p2[2 * e + 1] + w1[2 * e + 1] * p1[2 * e + 1] + w2[2 * e + 1] * cv1;
            const float z0 = bf_lo(zw[e]), z1 = bf_hi(zw[e]);
            o[2 * e] = bf_lo(bw[e]) * k0 * (z0 * sigmoidf_(z0)); o[2 * e + 1] = bf_hi(bw[e]) * k1 * (z1 * sigmoidf_(z1));
            p2[2 * e] = p1[2 * e]; p2[2 * e + 1] = p1[2 * e + 1]; p1[2 * e] = cv0; p1[2 * e + 1] = cv1;
        }
        v4u w; w.x = cvt_pk_bf16(o[0], o[1]); w.y = cvt_pk_bf16(o[2], o[3]); w.z = cvt_pk_bf16(o[4], o[5]); w.w = cvt_pk_bf16(o[6], o[7]);
        *(v4u*)(MIX + (size_t)(t0 + i) * DMIX + ch0) = w;
    }
}
__device__ __forceinline__ void final_row(const Args& a, int row, int lane) {
    const float* SSQ = (const float*)(a.ws + WS_SSQ);
    const float part = lane < 32 ? SSQ[(size_t)row * 32 + lane] : 0.f;
    const float rs = 1.0f / sqrtf(wave_sum(part) * (1.f / DM) + EPS);
    f32x4* orow = (f32x4*)(a.out + (size_t)row * DM) + lane; const f32x4* xr = (const f32x4*)(a.in[0] + (size_t)row * DM) + lane; const f32x4* gr = (const f32x4*)a.in[16] + lane;
#pragma unroll
    for (int j = 0; j < 8; ++j) { const f32x4 o = orow[64 * j], x = xr[64 * j], g = gr[64 * j]; orow[64 * j] = x + o * rs * g; }
}

__global__ void __launch_bounds__(NTHREADS, 2) fwd_kernel(Args args) {
    extern __shared__ __attribute__((aligned(16))) unsigned char lds_raw[];
    LAS unsigned char* lds = (LAS unsigned char*)lds_raw;
    const int tid = threadIdx.x, lane = tid & 63, wave = __builtin_amdgcn_readfirstlane(tid >> 6);
    const int G = gridDim.x, gw = blockIdx.x * NWAVES + wave, NGW = G * NWAVES;
    const int lo = args.ph_lo, hi = args.ph_hi;
    unsigned char* ws = args.ws;
    volatile LAS unsigned* MISC = (volatile LAS unsigned*)(lds + RING_BYTES);
    if (tid < 64) MISC[tid] = 0u;
    __syncthreads();
    if (lo < 0) cg::this_grid().sync();
    XcdBarrier bar; bar.bar = (unsigned*)(ws + WS_CTL); bar.x = 0; bar.st = nullptr;
    if (hi - lo > 1) bar = xcd_barrier_post((unsigned*)(ws + WS_CTL), MISC + 8);
#ifndef PROBE_PHASE
#define PROBE_PHASE -1
#endif
#define IN(k) (lo <= (k) && (k) < hi)
#define REPS(k) for (int rep_ = 0; rep_ < ((k) == PROBE_PHASE ? 2 : 1); ++rep_)
#define SEAM(k) do { if (IN(k) && IN((k) + 1)) { xcd_barrier(bar); } } while (0)
    if (IN(0)) REPS(0) {
        LAS float* scr = (LAS float*)(lds + wave * 16384);
        constexpr int I_IN = (DM / 64) * (NIN / 32), I_GLU = (DS / 64) * (DS / 32), I_OUT = (DMIX / 64) * (DM / 32);
        for (int it = gw; it < I_IN + I_GLU + I_OUT; it += NGW) {
            int r = it;
            if (r < I_IN) { p0_transpose_item(args.in[2], DM, NIN, (bf16*)(ws + WS_WIN), scr, r, lane); continue; } r -= I_IN;
            if (r < I_GLU) { p0_transpose_item(args.in[13], DS, DS, (bf16*)(ws + WS_WGLU), scr, r, lane); continue; } r -= I_GLU;
            p0_transpose_item(args.in[15], DMIX, DM, (bf16*)(ws + WS_WOUT), scr, r, lane);
        }
        for (int m = gw; m < M; m += NGW) rms_row_to_bf16(args.in[0] + (size_t)m * DM, args.in[1], (bf16*)(ws + WS_XN) + (size_t)m * DM, lane);
        { const int gt = (G - 1 - (int)blockIdx.x) * NTHREADS + tid; if (gt < NG * NP) p0_ssm_params(args, gt); }
        __syncthreads();
    }
    SEAM(0);
    if (IN(1)) REPS(1) {
        pg8::Gemm g{(const bf16*)(ws + WS_XN), (const bf16*)(ws + WS_WIN), M, NIN, DM}; pg8::StaticOrder S; S.init(M, NIN, G, (int)blockIdx.x);
        pg8::EpiProj E{(bf16*)(ws + WS_PROJ), NIN};
        pg8::gemm_phase<pg8::EpiProj, pg8::StaticOrder, true, true>(lds, g, S, E);
    }
    SEAM(1);
    if (IN(2)) REPS(2) { for (int it = gw; it < NSUP * NG; it += NGW) ssm_pass1(args, it, lane); }
    SEAM(2);
    if (IN(3)) REPS(3) {
        for (int it = gw; it < NCHUNK * NG; it += NGW) ssm_pass2(args, it, lane, lds + wave * 16384);
        for (int it = blockIdx.x * NTHREADS + tid; it < (M / 8) * (DC / 8); it += G * NTHREADS) conv_item(args, it);
        __syncthreads();
    }
    SEAM(3);
    if (IN(4)) REPS(4) {
        pg8::Gemm g{(const bf16*)(ws + WS_YG), (const bf16*)(ws + WS_WGLU), M, DS, DS}; pg8::StaticOrder S; S.init(M, DS, G, (int)blockIdx.x);
        pg8::EpiGlu E{(const bf16*)(ws + WS_YG), (const bf16*)(ws + WS_PROJ) + 5 * DC, NIN, args.in[14], (bf16*)(ws + WS_MIX) + DC, DMIX};
        pg8::gemm_phase<pg8::EpiGlu, pg8::StaticOrder, false, true>(lds, g, S, E);
    }
    SEAM(4);
    if (IN(5)) REPS(5) {
        pg8::Gemm g{(const bf16*)(ws + WS_MIX), (const bf16*)(ws + WS_WOUT), M, DM, DMIX}; pg8::StaticOrder S; S.init(M, DM, G, (int)blockIdx.x);
        pg8::EpiOut E{args.out, DM, (float*)(ws + WS_SSQ)};
        pg8::gemm_phase<pg8::EpiOut, pg8::StaticOrder, false, true>(lds, g, S, E);
    }
    SEAM(5);
    if (IN(6)) { for (int m = gw; m < M; m += NGW) final_row(args, m, lane); }
#undef IN
#undef SEAM
}

#ifndef MK_N_LAUNCHES
#define MK_N_LAUNCHES 1
#endif
constexpr int N_PHASES = 7;
extern "C" void kernel_launch(void* const* d_in, const int* in_sizes, int n_in, void* d_out, int out_size, void* d_ws, size_t ws_size, hipStream_t stream) {
    static int grid = 0;
    if (grid == 0) {
        if (n_in != 17 || out_size != M * DM || ws_size < WS_END) { fprintf(stderr, "kernel_launch: unexpected shapes (n_in %d, out %d, ws %zu)\n", n_in, out_size, ws_size); grid = -1; return; }
        int dev = 0, cus = 0, per_cu = 0;
        if (hipGetDevice(&dev) != hipSuccess || hipDeviceGetAttribute(&cus, hipDeviceAttributeMultiprocessorCount, dev) != hipSuccess) { grid = -1; return; }
        if (hipFuncSetAttribute((const void*)fwd_kernel, hipFuncAttributeMaxDynamicSharedMemorySize, LDS_BYTES) != hipSuccess) { fprintf(stderr, "kernel_launch: hipFuncSetAttribute failed\n"); grid = -1; return; }
        if (hipOccupancyMaxActiveBlocksPerMultiprocessor(&per_cu, (const void*)fwd_kernel, NTHREADS, LDS_BYTES) != hipSuccess || per_cu < 1) { fprintf(stderr, "kernel_launch: occupancy query gave %d\n", per_cu); (void)hipGetLastError(); grid = -1; return; }
        grid = cus * per_cu;
    }
    if (grid < 0) return;
    Args a{};
    for (int i = 0; i < 17; ++i) a.in[i] = (const float*)d_in[i];
    a.out = (float*)d_out; a.ws = (unsigned char*)d_ws;
    if (MK_N_LAUNCHES == 1) {
        if (hipMemsetAsync((char*)d_ws + WS_CTL, 0, CTL_ZERO_BYTES, stream) != hipSuccess) { fprintf(stderr, "kernel_launch: memset failed\n"); return; }
        a.ph_lo = 0; a.ph_hi = N_PHASES;
        void* kargs[] = {&a};
        const hipError_t e = hipLaunchCooperativeKernel((const void*)fwd_kernel, dim3(grid), dim3(NTHREADS), kargs, LDS_BYTES, stream);
        if (e != hipSuccess) fprintf(stderr, "kernel_launch: cooperative launch failed: %s (grid %d)\n", hipGetErrorString(e), grid);
    } else {
        for (int p = 0; p < N_PHASES; ++p) { a.ph_lo = p; a.ph_hi = p + 1; hipLaunchKernelGGL(fwd_kernel, dim3(grid), dim3(NTHREADS), LDS_BYTES, stream, a); }
    }
}
```
